# Optimizing an MI355X kernel written in HIP

```python
import math
import jax, jax.numpy as jnp
from jax import lax
import numpy as np

D_MODEL = 2048
BATCH = 4
SEQ = 4096
DEPTH = 2

HG_HEADS = 8
HG_DK = 128
HG_DV = 128
HG_WIDTH = HG_HEADS * HG_DK
HG_CHUNK = 64
F_MIN = 1e-30
MB_HEADS = 8
MB_HD = 128
MB_WIDTH = MB_HEADS * MB_HD
MB_BLOCK = 256
MB_TOPK = 3
MB_QCHUNK = 16
D_FF = 5632
MACARON_W = 0.5
N_SUB = 3
N_IN = 4 * HG_WIDTH + 3 * MB_WIDTH + 2 * D_MODEL
DN_ALPHA = (2 * DEPTH) ** 0.25
DN_BETA = (8 * DEPTH) ** -0.25
LN_EPS = 1e-5
RMS_EPS = 1e-6
NEG = -1e30

kernel_name = "hybrid_hgrn2_moba_macaron_deepnorm_adaln"


def layer_norm(x, g, b):
    xf = x.astype(jnp.float32)
    mu = xf.mean(-1, keepdims=True)
    var = jnp.square(xf - mu).mean(-1, keepdims=True)
    return ((xf - mu) * lax.rsqrt(var + LN_EPS) * g.astype(jnp.float32) + b.astype(jnp.float32)).astype(x.dtype)


def modulate(x, shift, scale):
    return x * (1 + scale[:, None, :]) + shift[:, None, :]


def swiglu(h, w_gate, w_up, w_down):
    return (jax.nn.silu(h @ w_gate) * (h @ w_up)) @ w_down


def hgrn2_mixer(q, f_logit, i, g, lb, norm_g):
    B, S, _ = q.shape
    nch = S // HG_CHUNK
    f32 = jnp.float32
    lb = lb.astype(f32)
    z = f_logit.astype(f32)
    f = lb + (1 - lb) * jax.nn.sigmoid(z)
    log_f = jnp.log(jnp.maximum(f, F_MIN))
    k = (1 - lb) * jax.nn.sigmoid(-z)
    qf = jax.nn.silu(q.astype(f32))

    def chunks(t):
        return t.reshape(B, nch, HG_CHUNK, HG_HEADS, -1).transpose(1, 0, 3, 2, 4)

    tri = jnp.tril(jnp.ones((HG_CHUNK, HG_CHUNK), bool))

    def step(state, inp):
        qc, kc, vc, lfc = inp
        b = jnp.cumsum(lfc, axis=2)
        diff = b[:, :, :, None, :] - b[:, :, None, :, :]
        decay = jnp.exp(jnp.where(tri[:, :, None], diff, NEG))
        attn = jnp.einsum('bhtd,bhsd,bhtsd->bhts', qc, kc, decay)
        o = attn @ vc + jnp.einsum('bhtd,bhde->bhte', qc * jnp.exp(b), state)
        b_last = b[:, :, -1:, :]
        new_state = jnp.exp(b_last[:, :, 0, :])[..., None] * state + jnp.einsum(
            'bhsd,bhse->bhde', kc * jnp.exp(b_last - b), vc)
        return new_state, o

    state0 = jnp.zeros((B, HG_HEADS, HG_DK, HG_DV), f32)
    _, o = lax.scan(step, state0, (chunks(qf), chunks(k), chunks(i.astype(f32)), chunks(log_f)))
    o = o.transpose(1, 0, 3, 2, 4).reshape(B, S, HG_HEADS, HG_DV)
    o = o * lax.rsqrt(jnp.mean(jnp.square(o), -1, keepdims=True) + RMS_EPS)
    o = o * norm_g.astype(f32).reshape(HG_HEADS, HG_DV)
    o = o * jax.nn.silu(g.astype(f32)).reshape(B, S, HG_HEADS, HG_DV)
    return o.reshape(B, S, HG_WIDTH).astype(q.dtype)


def moba_mixer(q, k, v):
    B, S, _ = q.shape
    f32 = jnp.float32
    nb = -(-S // MB_BLOCK)
    s_pad = nb * MB_BLOCK
    k_sel = min(MB_TOPK, nb)

    def heads(t):
        t = t.reshape(B, S, MB_HEADS, MB_HD).transpose(0, 2, 1, 3)
        return jnp.pad(t, ((0, 0), (0, 0), (0, s_pad - S), (0, 0)))

    qh, kh, vh = heads(q), heads(k), heads(v)
    kb = kh.reshape(B, MB_HEADS, nb, MB_BLOCK, MB_HD)
    vb = vh.reshape(B, MB_HEADS, nb, MB_BLOCK, MB_HD)
    k_mean = kb.astype(f32).mean(3)
    gate = jnp.einsum('bhsd,bhnd->bhsn', qh.astype(f32), k_mean)
    own_blk = jnp.arange(s_pad) // MB_BLOCK
    past = jnp.arange(nb)[None, :] < own_blk[:, None]
    gate = jnp.where(past, gate, NEG)
    _, idx = lax.top_k(gate, k_sel)
    valid = idx < own_blk[None, None, :, None]

    nq = s_pad // MB_QCHUNK

    def qchunks(t):
        return t.reshape(B, MB_HEADS, nq, MB_QCHUNK, t.shape[-1]).transpose(2, 0, 1, 3, 4)

    starts = jnp.arange(nq) * MB_QCHUNK
    b_ix = jnp.arange(B)[:, None, None, None]
    h_ix = jnp.arange(MB_HEADS)[None, :, None, None]
    scale = MB_HD ** -0.5

    def attend(args):
        qc, idc, vdc, start = args
        kg = kb[b_ix, h_ix, idc]
        vg = vb[b_ix, h_ix, idc]
        blk = start // MB_BLOCK
        k_own = lax.dynamic_index_in_dim(kb, blk, axis=2, keepdims=False)
        v_own = lax.dynamic_index_in_dim(vb, blk, axis=2, keepdims=False)
        s_sel = jnp.einsum('bhqd,bhqnpd->bhqnp', qc, kg).astype(f32) * scale
        s_sel = jnp.where(vdc[..., None], s_sel, NEG).reshape(B, MB_HEADS, MB_QCHUNK, k_sel * MB_BLOCK)
        s_own = jnp.einsum('bhqd,bhpd->bhqp', qc, k_own).astype(f32) * scale
        q_pos = start + jnp.arange(MB_QCHUNK)
        k_pos = blk * MB_BLOCK + jnp.arange(MB_BLOCK)
        s_own = jnp.where(k_pos[None, :] <= q_pos[:, None], s_own, NEG)
        p = jax.nn.softmax(jnp.concatenate([s_sel, s_own], axis=-1), axis=-1)
        p_sel = p[..., :k_sel * MB_BLOCK].reshape(B, MB_HEADS, MB_QCHUNK, k_sel, MB_BLOCK).astype(vg.dtype)
        p_own = p[..., k_sel * MB_BLOCK:].astype(v_own.dtype)
        return (jnp.einsum('bhqnp,bhqnpd->bhqd', p_sel, vg)
                + jnp.einsum('bhqp,bhpd->bhqd', p_own, v_own))

    out = lax.map(attend, (qchunks(qh), qchunks(idx), qchunks(valid), starts))
    out = out.transpose(1, 0, 3, 2, 4).reshape(B, s_pad, MB_WIDTH)
    return out[:, :S]


def hybrid_mixer(h, w_in, lb, norm_g, w_branch_a, w_branch_b, w_out):
    sizes = [HG_WIDTH] * 4 + [MB_WIDTH] * 3 + [D_MODEL] * 2
    cuts = [int(s) for s in np.cumsum(sizes)[:-1]]
    proj = h @ w_in
    hq, hf, hi, hg, mq, mk, mv, ga, gb = jnp.split(proj, cuts, axis=-1)
    y_a = hgrn2_mixer(hq, hf, hi, hg, lb, norm_g) @ w_branch_a
    y_b = moba_mixer(mq, mk, mv) @ w_branch_b
    merged = jax.nn.sigmoid(ga) * y_a + jax.nn.sigmoid(gb) * y_b
    return merged @ w_out


def setup_inputs(seed: int = 0) -> dict:
    key = jax.random.key(seed)
    ks = jax.random.split(key, 16)
    nrm = jax.random.normal
    f32 = jnp.float32
    x = nrm(ks[0], (BATCH, SEQ, D_MODEL), f32)
    c = nrm(ks[1], (BATCH, D_MODEL), f32)
    ada_w = nrm(ks[2], (DEPTH, D_MODEL, N_SUB * 3 * D_MODEL), f32) * (0.1 * D_MODEL ** -0.5)
    ada_b = nrm(ks[3], (DEPTH, N_SUB * 3 * D_MODEL), f32) * 0.01
    ln_g = 1.0 + 0.02 * nrm(ks[4], (DEPTH, N_SUB, D_MODEL), f32)
    ln_b = 0.02 * nrm(ks[5], (DEPTH, N_SUB, D_MODEL), f32)
    ffn_w_gate = nrm(ks[6], (DEPTH, 2, D_MODEL, D_FF), f32) * D_MODEL ** -0.5
    ffn_w_up = nrm(ks[7], (DEPTH, 2, D_MODEL, D_FF), f32) * D_MODEL ** -0.5
    ffn_w_down = nrm(ks[8], (DEPTH, 2, D_FF, D_MODEL), f32) * (D_FF ** -0.5 * DN_BETA)
    w_in = nrm(ks[9], (DEPTH, D_MODEL, N_IN), f32) * D_MODEL ** -0.5
    hg_lb_logits = 0.5 * nrm(ks[10], (DEPTH, HG_WIDTH), f32)
    hg_norm_g = 1.0 + 0.02 * nrm(ks[11], (DEPTH, HG_WIDTH), f32)
    w_branch_a = nrm(ks[12], (DEPTH, HG_WIDTH, D_MODEL), f32) * HG_WIDTH ** -0.5
    w_branch_b = nrm(ks[13], (DEPTH, MB_WIDTH, D_MODEL), f32) * MB_WIDTH ** -0.5
    w_out = nrm(ks[14], (DEPTH, D_MODEL, D_MODEL), f32) * (D_MODEL ** -0.5 * DN_BETA)
    return {"x": x, "c": c, "ada_w": ada_w, "ada_b": ada_b, "ln_g": ln_g, "ln_b": ln_b,
            "ffn_w_gate": ffn_w_gate, "ffn_w_up": ffn_w_up, "ffn_w_down": ffn_w_down,
            "w_in": w_in, "hg_lb_logits": hg_lb_logits, "hg_norm_g": hg_norm_g,
            "w_branch_a": w_branch_a, "w_branch_b": w_branch_b, "w_out": w_out}


def reference(x, c, ada_w, ada_b, ln_g, ln_b, ffn_w_gate, ffn_w_up, ffn_w_down,
              w_in, hg_lb_logits, hg_norm_g, w_branch_a, w_branch_b, w_out):
    B = x.shape[0]
    p_lb = jax.nn.softmax(hg_lb_logits.astype(jnp.float32), axis=0)
    lower_bounds = jnp.cumsum(p_lb, axis=0) - p_lb[0]
    cond = jax.nn.silu(c)
    for l in range(DEPTH):
        mod = (cond @ ada_w[l] + ada_b[l]).reshape(B, N_SUB, 3, D_MODEL)
        shift, scale, gate = mod[:, :, 0], mod[:, :, 1], mod[:, :, 2]
        h = modulate(x, shift[:, 0], scale[:, 0])
        y = swiglu(h, ffn_w_gate[l, 0], ffn_w_up[l, 0], ffn_w_down[l, 0])
        x = layer_norm(DN_ALPHA * x + MACARON_W * (1 + gate[:, 0, None, :]) * y, ln_g[l, 0], ln_b[l, 0])
        h = modulate(x, shift[:, 1], scale[:, 1])
        y = hybrid_mixer(h, w_in[l], lower_bounds[l], hg_norm_g[l], w_branch_a[l], w_branch_b[l], w_out[l])
        x = layer_norm(DN_ALPHA * x + (1 + gate[:, 1, None, :]) * y, ln_g[l, 1], ln_b[l, 1])
        h = modulate(x, shift[:, 2], scale[:, 2])
        y = swiglu(h, ffn_w_gate[l, 1], ffn_w_up[l, 1], ffn_w_down[l, 1])
        x = layer_norm(DN_ALPHA * x + MACARON_W * (1 + gate[:, 2, None, :]) * y, ln_g[l, 2], ln_b[l, 2])
    return x
```

```cpp
#include <hip/hip_runtime.h>
#include <cstdio>
#include <cstdint>
#include <cmath>
#ifndef PG8_UNIT_REP
#define PG8_UNIT_REP 1
#endif
namespace pg8 {
#define PG8_LAS __attribute__((address_space(3)))
typedef unsigned short bf16_t;
typedef short bf16x8 __attribute__((ext_vector_type(8)));
typedef float f32x4 __attribute__((ext_vector_type(4)));
typedef unsigned u32x4 __attribute__((ext_vector_type(4)));
constexpr int BM = 256, BK = 64, HALF = 128, HTB = HALF * BK * 2  , STAGE_BYTES = 8 * HTB, NXCD = 8, WGM = 8;

__host__ __device__ __forceinline__ int lds_byte(int r, int c) { const int st = (r >> 4) * 2 + (c >> 5), rr = r & 15, cc = c & 31, ob = rr * 64 + cc * 2; return st * 1024 + (ob ^ (((ob >> 9) & 1) << 5)); }
__host__ __device__ __forceinline__ void stage_rc(int b, int& R, int& C) { const int st = b / 1024, sb = b % 1024, swz = sb ^ (((sb >> 9) & 1) << 5); R = (st >> 1) * 16 + swz / 64; C = (st & 1) * 32 + (swz % 64) / 2; }
__host__ __device__ __forceinline__ int perm32(int rho) { const int n = rho >> 4, i = rho & 15; return 8 * (i >> 2) + 4 * n + (i & 3); }

struct Unit { int pm, pn; };
struct Gemm { const bf16_t* A; const bf16_t* Bt; int M, N, K; };

struct StaticOrder {
    int nM, nN, nwg, G, c;
    __host__ __device__ void init(int M, int N, int G_, int c_) { nM = M / BM; nN = N / BM; nwg = nM * nN; G = G_; c = c_; }
    __host__ __device__ bool next(int i, Unit& u) const {
        const long L = (long)(i / PG8_UNIT_REP) * G + c; if (L >= nwg) return false;
        int wgid = (int)L; { const int q = nwg / NXCD, r = nwg % NXCD, xcd = wgid % NXCD, off = wgid / NXCD; wgid = (xcd < r ? xcd * (q + 1) : r * (q + 1) + (xcd - r) * q) + off; }
        const int nig = WGM * nN, gid = wgid / nig, fm = gid * WGM, gsz = (nM - fm) < WGM ? (nM - fm) : WGM;
        u.pm = fm + ((wgid % nig) % gsz); u.pn = (wgid % nig) / gsz; return true;
    }
    __device__ __forceinline__ void a_ready(const Unit&) const {}
    __device__ __forceinline__ void done(const Unit&) const {}
};
__device__ __forceinline__ unsigned cvt_pk_bf16(float lo, float hi) { unsigned r; asm volatile("v_cvt_pk_bf16_f32 %0, %1, %2" : "=v"(r) : "v"(lo), "v"(hi)); return r; }
typedef float f32x2 __attribute__((ext_vector_type(2)));
__device__ __forceinline__ float silu_f(float v) { return v * __builtin_amdgcn_rcpf(1.f + __builtin_amdgcn_exp2f(-1.4426950408889634f * v)); }
__device__ __forceinline__ float sigm_f(float v) { return __builtin_amdgcn_rcpf(1.f + __builtin_amdgcn_exp2f(-1.4426950408889634f * v)); }
__device__ __forceinline__ float bf_lo(unsigned w) { return __uint_as_float(w << 16); }
__device__ __forceinline__ float bf_hi(unsigned w) { return __uint_as_float(w & 0xffff0000u); }

typedef _Float16 h2_t __attribute__((ext_vector_type(2)));
__device__ __forceinline__ unsigned pk_h2(float a, float b) { h2_t v = {(_Float16)a, (_Float16)b}; return __builtin_bit_cast(unsigned, v); }
__device__ __forceinline__ float h_lo(unsigned w) { return (float)__builtin_bit_cast(h2_t, w).x; }
__device__ __forceinline__ float h_hi(unsigned w) { return (float)__builtin_bit_cast(h2_t, w).y; }
struct EpiGateUp {
    static constexpr bool PERM = true, AFTER_DRAIN = false; static constexpr int MID_T = -1;
    bf16_t* O; int ldc;
    __device__ __forceinline__ void operator()(const f32x4 (&acc)[2][2][4][2], const Unit& u, int wr, int wc, int fr, int fq) const {
        const int row0 = u.pm * BM + wr * 64 + fr, col0 = u.pn * HALF + wc * 32 + 8 * fq;
#pragma unroll
        for (int ai = 0; ai < 2; ++ai)
#pragma unroll
            for (int m = 0; m < 4; ++m) { bf16_t* rowp = O + (size_t)(row0 + ai * HALF + m * 16) * ldc + col0;
                const f32x4 g0 = acc[ai][0][m][0], g1 = acc[ai][0][m][1], u0 = acc[ai][1][m][0], u1 = acc[ai][1][m][1];
                f32x4 a0, a1;
#pragma unroll
                for (int j = 0; j < 4; ++j) { a0[j] = g0[j] * u0[j] * __builtin_amdgcn_rcpf(1.f + __builtin_amdgcn_exp2f(g0[j])); a1[j] = g1[j] * u1[j] * __builtin_amdgcn_rcpf(1.f + __builtin_amdgcn_exp2f(g1[j])); }
                u32x4 w; w.x = cvt_pk_bf16(a0[0], a0[1]); w.y = cvt_pk_bf16(a0[2], a0[3]); w.z = cvt_pk_bf16(a1[0], a1[1]); w.w = cvt_pk_bf16(a1[2], a1[3]);
                *(u32x4*)rowp = w; }
    }
};

template <size_t oQ, size_t oV, size_t oSG, size_t oMQ, size_t oMK, size_t oMV, size_t oGA, size_t oGB, size_t zbadd> struct EpiInProj {
    static constexpr bool PERM = true, AFTER_DRAIN = false; static constexpr int MID_T = -1;
    static constexpr float qscale = 0.08838834764831845f * 1.4426950408889634f;
    static constexpr size_t oZ = 0;
    unsigned char* R;
    unsigned char* ZB;
    __device__ __forceinline__ void operator()(const f32x4 (&acc)[2][2][4][2], const Unit& u, int wr, int wc, int fr, int fq) const {
        const int row0 = u.pm * BM + wr * 64 + fr; const int pn = u.pn;
        int mode = 0, ld = 1024, ct = pn & 3; size_t off = 0;
        if (pn < 28) { const int t = pn >> 2;
            if (t == 0) { off = oQ; mode = 1; } else if (t == 1) { off = oZ; mode = 3; } else if (t == 2) { off = oV; } else if (t == 3) { off = oSG; mode = 1; }
            else if (t == 4) { off = oMQ; mode = 4; } else if (t == 5) { off = oMK; } else { off = oMV; } }
        else if (pn < 36) { off = oGA; mode = 2; ld = 2048; ct = pn - 28; }
        else { off = oGB; mode = 2; ld = 2048; ct = pn - 36; }
        const int col0 = ct * BM + wc * 32 + 8 * fq;
        if (mode == 3) {
            unsigned short* base = (unsigned short*)(ZB + (size_t)(u.pm >> 4) * zbadd);
#pragma unroll
            for (int ai = 0; ai < 2; ++ai)
#pragma unroll
                for (int m = 0; m < 4; ++m) { unsigned short* rowp = base + (size_t)(row0 + ai * HALF + m * 16) * ld + col0;
#pragma unroll
                    for (int bj = 0; bj < 2; ++bj) { const f32x4 v0 = acc[ai][bj][m][0], v1 = acc[ai][bj][m][1];
                        u32x4 w; w.x = pk_h2(v0[0], v0[1]); w.y = pk_h2(v0[2], v0[3]); w.z = pk_h2(v1[0], v1[1]); w.w = pk_h2(v1[2], v1[3]); *(u32x4*)(rowp + bj * HALF) = w; } }
        } else {
            bf16_t* base = (bf16_t*)(R + off);
#pragma unroll
            for (int ai = 0; ai < 2; ++ai)
#pragma unroll
                for (int m = 0; m < 4; ++m) { bf16_t* rowp = base + (size_t)(row0 + ai * HALF + m * 16) * ld + col0;
#pragma unroll
                    for (int bj = 0; bj < 2; ++bj) { f32x4 v0 = acc[ai][bj][m][0], v1 = acc[ai][bj][m][1];
                        if (mode == 1) {
#pragma unroll
                            for (int j = 0; j < 4; ++j) { v0[j] = silu_f(v0[j]); v1[j] = silu_f(v1[j]); } }
                        else if (mode == 2) {
#pragma unroll
                            for (int j = 0; j < 4; ++j) { v0[j] = sigm_f(v0[j]); v1[j] = sigm_f(v1[j]); } }
                        else if (mode == 4) { v0 = v0 * qscale; v1 = v1 * qscale; }
                        u32x4 w; w.x = cvt_pk_bf16(v0[0], v0[1]); w.y = cvt_pk_bf16(v0[2], v0[3]); w.z = cvt_pk_bf16(v1[0], v1[1]); w.w = cvt_pk_bf16(v1[2], v1[3]);
                        *(u32x4*)(rowp + bj * HALF) = w; } }
        }
    }
};

template <bool XF32, int LDC, int GATE_BSTRIDE, int ROWS_PER_BATCH, int WGT_HALF  > struct EpiResid {
    static constexpr bool PERM = true, AFTER_DRAIN = false; static constexpr int MID_T = -1;
    static constexpr float alpha = 1.4142135623730951f, wgt = WGT_HALF ? 0.5f : 1.0f;
    const float* xf32; unsigned short* out; const float* gate;
    const float* stats; const float* lng; const float* lnb;
    __device__ __forceinline__ void operator()(const f32x4 (&acc)[2][2][4][2], const Unit& u, int wr, int wc, int fr, int fq) const {
        int z_; asm volatile("v_mov_b32 %0, 0" : "=v"(z_));
        const int row0 = u.pm * BM + wr * 64 + (fr + z_), col0 = u.pn * BM + wc * 32 + 8 * (fq + z_);
        const float* gv = gate + (size_t)((u.pm * BM) / ROWS_PER_BATCH) * GATE_BSTRIDE;
        if constexpr (!XF32) {
            f32x2 stA[4], stB[4]; u32x4 xwA[4], xwB[4]; f32x4 gmv[2], lgv[2], lbv[2];
            const unsigned ob = (unsigned)(row0 * LDC + col0) * 2u, sb = (unsigned)row0 * 8u;
#define ER_ROWS(ST, XW, ai_, bj_) do { _Pragma("unroll") for (int m = 0; m < 4; ++m) { \
                ST[m] = *(const f32x2*)((const char*)stats + (sb + (unsigned)(((ai_) * HALF + m * 16) * 8))); XW[m] = *(const u32x4*)((const char*)out + (ob + (unsigned)((((ai_) * HALF + m * 16) * LDC + (bj_) * HALF) * 2))); } } while (0)
#define ER_COLS(bj_) do { _Pragma("unroll") for (int n = 0; n < 2; ++n) { gmv[n] = (*(const f32x4*)(gv + col0 + (bj_) * HALF + n * 4) + 1.0f) * wgt; \
                lgv[n] = *(const f32x4*)(lng + col0 + (bj_) * HALF + n * 4) * alpha; lbv[n] = *(const f32x4*)(lnb + col0 + (bj_) * HALF + n * 4) * alpha; } } while (0)
#define ER_DO(ST, XW, ai_, bj_) do { _Pragma("unroll") for (int m = 0; m < 4; ++m) { const u32x4 w = XW[m]; \
                f32x4 x0 = (f32x4){h_lo(w.x), h_hi(w.x), h_lo(w.y), h_hi(w.y)}, x1 = (f32x4){h_lo(w.z), h_hi(w.z), h_lo(w.w), h_hi(w.w)}; \
                x0 = (x0 - ST[m].x) * ST[m].y * lgv[0] + lbv[0]; x1 = (x1 - ST[m].x) * ST[m].y * lgv[1] + lbv[1]; \
                const f32x4 v0 = x0 + gmv[0] * acc[ai_][bj_][m][0], v1 = x1 + gmv[1] * acc[ai_][bj_][m][1]; \
                u32x4 o; o.x = pk_h2(v0[0], v0[1]); o.y = pk_h2(v0[2], v0[3]); o.z = pk_h2(v1[0], v1[1]); o.w = pk_h2(v1[2], v1[3]); \
                *(u32x4*)((char*)out + (ob + (unsigned)((((ai_) * HALF + m * 16) * LDC + (bj_) * HALF) * 2))) = o; } } while (0)
            ER_COLS(0); ER_ROWS(stA, xwA, 0, 0);
            ER_ROWS(stB, xwB, 1, 0); ER_DO(stA, xwA, 0, 0);
            ER_ROWS(stA, xwA, 0, 1); ER_DO(stB, xwB, 1, 0);
            ER_COLS(1); ER_ROWS(stB, xwB, 1, 1); ER_DO(stA, xwA, 0, 1);
            ER_DO(stB, xwB, 1, 1);
#undef ER_ROWS
#undef ER_COLS
#undef ER_DO
        } else {
#pragma unroll
        for (int ai = 0; ai < 2; ++ai)
#pragma unroll
        for (int bj = 0; bj < 2; ++bj) {
            f32x2 st[4]; f32x4 xa[4], xb[4]; u32x4 xw[4]; f32x4 gmv[2], lgv[2], lbv[2];
#pragma unroll
            for (int n = 0; n < 2; ++n) { gmv[n] = (*(const f32x4*)(gv + col0 + bj * HALF + n * 4) + 1.0f) * wgt;
                if (!XF32) { lgv[n] = *(const f32x4*)(lng + col0 + bj * HALF + n * 4) * alpha; lbv[n] = *(const f32x4*)(lnb + col0 + bj * HALF + n * 4) * alpha; } }
#pragma unroll
            for (int m = 0; m < 4; ++m) { const int row = row0 + ai * HALF + m * 16; const size_t ro = (size_t)row * LDC + col0;
                st[m] = (f32x2){0.f, 1.f}; if (!XF32) st[m] = *(const f32x2*)(stats + 2 * (size_t)row);
                if (XF32) { xa[m] = *(const f32x4*)(xf32 + ro + bj * HALF); xb[m] = *(const f32x4*)(xf32 + ro + bj * HALF + 4); }
                else xw[m] = *(const u32x4*)(out + ro + bj * HALF); }
#pragma unroll
            for (int m = 0; m < 4; ++m) { const int row = row0 + ai * HALF + m * 16; const size_t ro = (size_t)row * LDC + col0; f32x4 x0, x1;
                if (XF32) { x0 = xa[m] * alpha; x1 = xb[m] * alpha; }
                else { const u32x4 w = xw[m];
                    x0 = (f32x4){h_lo(w.x), h_hi(w.x), h_lo(w.y), h_hi(w.y)}; x1 = (f32x4){h_lo(w.z), h_hi(w.z), h_lo(w.w), h_hi(w.w)};
                    x0 = (x0 - st[m].x) * st[m].y * lgv[0] + lbv[0]; x1 = (x1 - st[m].x) * st[m].y * lgv[1] + lbv[1]; }
                const f32x4 v0 = x0 + gmv[0] * acc[ai][bj][m][0], v1 = x1 + gmv[1] * acc[ai][bj][m][1];
                u32x4 o; o.x = pk_h2(v0[0], v0[1]); o.y = pk_h2(v0[2], v0[3]); o.z = pk_h2(v1[0], v1[1]); o.w = pk_h2(v1[2], v1[3]);
                *(u32x4*)(out + ro + bj * HALF) = o; }
        }
        }
    }
};

struct EpiMerge {
    static constexpr bool PERM = true, AFTER_DRAIN = false; static constexpr int MID_T = 16;
    const bf16_t* sga; const bf16_t* sgb; bf16_t* O; int ldc;
    __device__ __forceinline__ void mid(f32x4 (&acc)[2][2][4][2], const Unit& u, int wr, int wc, int fr, int fq) const {
        int z_; asm volatile("v_mov_b32 %0, 0" : "=v"(z_));
        const int row0 = u.pm * BM + wr * 64 + fr + z_, col0 = u.pn * BM + wc * 32 + 8 * fq;
        const unsigned ob = (unsigned)(row0 * ldc + col0) * 2u;
        u32x4 gaA[4], gbA[4], gaB[4], gbB[4];
#define EM_LD(GA, GB, ai_, bj_) do { _Pragma("unroll") for (int m = 0; m < 4; ++m) { const unsigned o_ = ob + (unsigned)((((ai_) * HALF + m * 16) * ldc + (bj_) * HALF) * 2); \
            GA[m] = *(const u32x4*)((const char*)sga + o_); GB[m] = *(const u32x4*)((const char*)sgb + o_); } } while (0)
#define EM_DO(GA, GB, ai_, bj_) do { _Pragma("unroll") for (int m = 0; m < 4; ++m) { const u32x4 a = GA[m], b = GB[m]; \
            f32x4 r0 = {bf_lo(a.x) * __builtin_amdgcn_rcpf(fmaxf(bf_lo(b.x), 1e-30f)), bf_hi(a.x) * __builtin_amdgcn_rcpf(fmaxf(bf_hi(b.x), 1e-30f)), bf_lo(a.y) * __builtin_amdgcn_rcpf(fmaxf(bf_lo(b.y), 1e-30f)), bf_hi(a.y) * __builtin_amdgcn_rcpf(fmaxf(bf_hi(b.y), 1e-30f))}; \
            f32x4 r1 = {bf_lo(a.z) * __builtin_amdgcn_rcpf(fmaxf(bf_lo(b.z), 1e-30f)), bf_hi(a.z) * __builtin_amdgcn_rcpf(fmaxf(bf_hi(b.z), 1e-30f)), bf_lo(a.w) * __builtin_amdgcn_rcpf(fmaxf(bf_lo(b.w), 1e-30f)), bf_hi(a.w) * __builtin_amdgcn_rcpf(fmaxf(bf_hi(b.w), 1e-30f))}; \
            acc[ai_][bj_][m][0] = acc[ai_][bj_][m][0] * r0; acc[ai_][bj_][m][1] = acc[ai_][bj_][m][1] * r1; } } while (0)
        EM_LD(gaA, gbA, 0, 0);
        EM_LD(gaB, gbB, 0, 1); EM_DO(gaA, gbA, 0, 0);
        EM_LD(gaA, gbA, 1, 0); EM_DO(gaB, gbB, 0, 1);
        EM_LD(gaB, gbB, 1, 1); EM_DO(gaA, gbA, 1, 0);
        EM_DO(gaB, gbB, 1, 1);
#undef EM_LD
#undef EM_DO
        asm volatile("s_waitcnt vmcnt(0)" ::: "memory");
    }
    __device__ __forceinline__ void operator()(const f32x4 (&acc)[2][2][4][2], const Unit& u, int wr, int wc, int fr, int fq) const {
        int z_; asm volatile("v_mov_b32 %0, 0" : "=v"(z_));
        const int row0 = u.pm * BM + wr * 64 + (fr + z_), col0 = u.pn * BM + wc * 32 + 8 * (fq + z_);
        const unsigned ob = (unsigned)(row0 * ldc + col0) * 2u;
        u32x4 gbA[4], gbB[4];
#define EF_LD(GB, ai_, bj_) do { _Pragma("unroll") for (int m = 0; m < 4; ++m) GB[m] = *(const u32x4*)((const char*)sgb + (ob + (unsigned)((((ai_) * HALF + m * 16) * ldc + (bj_) * HALF) * 2))); } while (0)
#define EF_DO(GB, ai_, bj_) do { _Pragma("unroll") for (int m = 0; m < 4; ++m) { const u32x4 b = GB[m]; f32x4 v0 = acc[ai_][bj_][m][0], v1 = acc[ai_][bj_][m][1]; \
            v0[0] *= bf_lo(b.x); v0[1] *= bf_hi(b.x); v0[2] *= bf_lo(b.y); v0[3] *= bf_hi(b.y); v1[0] *= bf_lo(b.z); v1[1] *= bf_hi(b.z); v1[2] *= bf_lo(b.w); v1[3] *= bf_hi(b.w); \
            u32x4 w; w.x = cvt_pk_bf16(v0[0], v0[1]); w.y = cvt_pk_bf16(v0[2], v0[3]); w.z = cvt_pk_bf16(v1[0], v1[1]); w.w = cvt_pk_bf16(v1[2], v1[3]); \
            *(u32x4*)((char*)O + (ob + (unsigned)((((ai_) * HALF + m * 16) * ldc + (bj_) * HALF) * 2))) = w; } } while (0)
        EF_LD(gbA, 0, 0);
        EF_LD(gbB, 0, 1); EF_DO(gbA, 0, 0);
        EF_LD(gbA, 1, 0); EF_DO(gbB, 0, 1);
        EF_LD(gbB, 1, 1); EF_DO(gbA, 1, 0);
        EF_DO(gbB, 1, 1);
#undef EF_LD
#undef EF_DO
    }
};

struct RevOrder : StaticOrder {
    __device__ __forceinline__ bool next(int i, Unit& u) const { const bool r = StaticOrder::next(i, u); u.pn = nN - 1 - u.pn; return r; }
};
template <class Epi, class Sched, bool ALIGN_EPI = false, bool SP2 = false>
__device__ __forceinline__ void gemm_phase(PG8_LAS unsigned char* lds, const Gemm g, const Sched& S, const Epi& E) {
    const int tid = threadIdx.x, wid = __builtin_amdgcn_readfirstlane(tid >> 6), lane = tid & 63, wr = wid >> 2, wc = wid & 3, fr = lane & 15, fq = lane >> 4;
    const int K = g.K, nt = K / BK;
    unsigned voffA[2], voffB[2];
#pragma unroll
    for (int i = 0; i < 2; ++i) { int R, C; stage_rc(tid * 16 + i * 8192, R, C); const int Rb = Epi::PERM ? ((R & ~31) + perm32(R & 31)) : R;
        voffA[i] = (unsigned)(R * K + C) * 2u; voffB[i] = (unsigned)(Rb * K + C) * 2u; }
    const size_t kstep = (size_t)(BK * 2);
    const size_t hstep = (size_t)HALF * K * 2;
    const size_t tstep = 2 * hstep;
    const unsigned ldsw = (unsigned)wid * 1024u;
    const int aoff = lds_byte(wr * 64 + fr, fq * 8), boff = lds_byte(wc * 32 + fr, fq * 8);
#define PG8_SA(b, h) (((b) * 2 + (h)) * HTB)
#define PG8_SB(b, h) ((4 + (b) * 2 + (h)) * HTB)
#define PG8_STAGE(bufoff, gbase, voff) do { _Pragma("unroll") for (int _i = 0; _i < 2; ++_i) \
        __builtin_amdgcn_global_load_lds((const unsigned*)((const char*)(gbase) + (voff)[_i]), (PG8_LAS unsigned*)(lds + (bufoff) + ldsw + _i * 8192), 16, 0, 0); } while (0)
#define PG8_LDA(dst, b, h) do { _Pragma("unroll") for (int m = 0; m < 4; ++m) _Pragma("unroll") for (int k = 0; k < 2; ++k) dst[m][k] = *(const PG8_LAS bf16x8*)(lds + PG8_SA(b, h) + aoff + m * 2048 + k * 1024); } while (0)
#define PG8_LDB(dst, b, h) do { _Pragma("unroll") for (int n = 0; n < 2; ++n) _Pragma("unroll") for (int k = 0; k < 2; ++k) dst[n][k] = *(const PG8_LAS bf16x8*)(lds + PG8_SB(b, h) + boff + n * 2048 + k * 1024); } while (0)
#define PG8_MMA(ai, bj, At, Bt) do { __builtin_amdgcn_s_setprio(1); _Pragma("unroll") for (int m = 0; m < 4; ++m) _Pragma("unroll") for (int n = 0; n < 2; ++n) _Pragma("unroll") for (int k = 0; k < 2; ++k) \
        acc[ai][bj][m][n] = __builtin_amdgcn_mfma_f32_16x16x32_bf16(Bt[n][k], At[m][k], acc[ai][bj][m][n], 0, 0, 0); __builtin_amdgcn_s_setprio(0); } while (0)
#define PG8_WAIT_V(n) asm volatile("s_waitcnt vmcnt(" #n ")" ::: "memory")
#define PG8_WAIT_L(n) asm volatile("s_waitcnt lgkmcnt(" #n ")" ::: "memory")
#define PG8_BAR __builtin_amdgcn_s_barrier()
#define PG8_SCHED __builtin_amdgcn_sched_barrier(0)
    Unit cur, nxt; int ui = 0;
    if (!S.next(0, cur)) return;
    f32x4 acc[2][2][4][2];
#pragma unroll
    for (int a = 0; a < 2; ++a)
#pragma unroll
        for (int b = 0; b < 2; ++b)
#pragma unroll
            for (int m = 0; m < 4; ++m)
#pragma unroll
                for (int n = 0; n < 2; ++n) acc[a][b][m][n] = (f32x4){0.f, 0.f, 0.f, 0.f};
    bf16x8 At[4][2], B0[2][2], B1[2][2];
    const char* cA = (const char*)g.A + (size_t)cur.pm * tstep; const char* cB = (const char*)g.Bt + (size_t)cur.pn * tstep;
    S.a_ready(cur);
    if constexpr (SP2) {
        PG8_STAGE(PG8_SB(0, 0), cB, voffB); PG8_STAGE(PG8_SB(0, 1), cB + hstep, voffB); PG8_STAGE(PG8_SA(0, 0), cA, voffA); PG8_STAGE(PG8_SA(0, 1), cA + hstep, voffA);
        if (wr == 1) PG8_BAR;
        PG8_WAIT_V(2); PG8_BAR;
        PG8_STAGE(PG8_SB(1, 0), cB + kstep, voffB); PG8_STAGE(PG8_SA(1, 0), cA + kstep, voffA); PG8_STAGE(PG8_SB(1, 1), cB + hstep + kstep, voffB);
        PG8_WAIT_V(6); PG8_BAR;
    } else {
        PG8_STAGE(PG8_SB(0, 0), cB, voffB); PG8_STAGE(PG8_SA(0, 0), cA, voffA); PG8_STAGE(PG8_SB(0, 1), cB + hstep, voffB); PG8_STAGE(PG8_SA(0, 1), cA + hstep, voffA);
        if (wr == 1) PG8_BAR;
        PG8_WAIT_V(4); PG8_BAR;
        PG8_STAGE(PG8_SB(1, 0), cB + kstep, voffB); PG8_STAGE(PG8_SA(1, 0), cA + kstep, voffA); PG8_STAGE(PG8_SB(1, 1), cB + hstep + kstep, voffB);
        PG8_WAIT_V(6); PG8_BAR;
    }
    for (;;) {
        const bool has_next = S.next(ui + 1, nxt);
        const char* nA = has_next ? (const char*)g.A + (size_t)nxt.pm * tstep : cA; const char* nB = has_next ? (const char*)g.Bt + (size_t)nxt.pn * tstep : cB;
        constexpr int NSEG = Epi::MID_T >= 0 ? 2 : 1;
#pragma unroll 1
        for (int seg = 0; seg < NSEG; ++seg) {
        if constexpr (Epi::MID_T >= 0) { if (seg == 1) E.mid(acc, cur, wr, wc, fr, fq); }
        const int t_lo = (NSEG == 2 && seg == 1) ? Epi::MID_T : 0, t_hi = (NSEG == 2 && seg == 0) ? Epi::MID_T : nt;
        for (int t = t_lo; t < t_hi; t += 2) {
            const bool last = (t == nt - 2);
            const char* a1 = cA + (size_t)(t + 1) * kstep;
            const char* a2 = last ? nA : cA + (size_t)(t + 2) * kstep; const char* b2 = last ? nB : cB + (size_t)(t + 2) * kstep;
            const char* a3 = a2 + kstep; const char* b3 = b2 + kstep;
            if (last && has_next) S.a_ready(nxt);
            if constexpr (SP2) {
            PG8_LDB(B0, 0, 0); PG8_LDB(B1, 0, 1); PG8_SCHED; PG8_LDA(At, 0, 0); PG8_STAGE(PG8_SA(1, 1), a1 + hstep, voffA);
            PG8_WAIT_V(8); PG8_WAIT_L(0); PG8_BAR; PG8_MMA(0, 0, At, B0); PG8_MMA(0, 1, At, B1); PG8_BAR; PG8_SCHED;
            PG8_LDA(At, 0, 1); PG8_STAGE(PG8_SB(0, 0), b2, voffB); PG8_STAGE(PG8_SB(0, 1), b2 + hstep, voffB); PG8_STAGE(PG8_SA(0, 0), a2, voffA);
            PG8_WAIT_V(8); PG8_WAIT_L(0); PG8_BAR; PG8_MMA(1, 0, At, B0); PG8_MMA(1, 1, At, B1); PG8_BAR; PG8_SCHED;
            PG8_LDB(B0, 1, 0); PG8_LDB(B1, 1, 1); PG8_SCHED; PG8_LDA(At, 1, 0); PG8_STAGE(PG8_SA(0, 1), a2 + hstep, voffA);
            PG8_WAIT_V(8); PG8_WAIT_L(0); PG8_BAR; PG8_MMA(0, 0, At, B0); PG8_MMA(0, 1, At, B1); PG8_BAR; PG8_SCHED;
            PG8_LDA(At, 1, 1); PG8_STAGE(PG8_SB(1, 0), b3, voffB); PG8_STAGE(PG8_SB(1, 1), b3 + hstep, voffB); PG8_STAGE(PG8_SA(1, 0), a3, voffA);
            PG8_WAIT_V(8); PG8_WAIT_L(0); PG8_BAR; PG8_MMA(1, 0, At, B0); PG8_MMA(1, 1, At, B1); PG8_BAR; PG8_SCHED;
            } else {
            PG8_LDB(B0, 0, 0); PG8_SCHED; PG8_LDA(At, 0, 0); PG8_STAGE(PG8_SA(1, 1), a1 + hstep, voffA);
            PG8_WAIT_L(8); PG8_BAR; PG8_WAIT_L(0); PG8_MMA(0, 0, At, B0); PG8_BAR; PG8_SCHED;
            PG8_LDB(B1, 0, 1); PG8_STAGE(PG8_SB(0, 0), b2, voffB);
            PG8_BAR; PG8_WAIT_L(0); PG8_MMA(0, 1, At, B1); PG8_BAR;
            PG8_LDA(At, 0, 1); PG8_STAGE(PG8_SA(0, 0), a2, voffA);
            PG8_BAR; PG8_WAIT_L(0); PG8_MMA(1, 0, At, B0); PG8_BAR; PG8_SCHED;
            PG8_STAGE(PG8_SB(0, 1), b2 + hstep, voffB);
            PG8_WAIT_V(6); PG8_BAR; PG8_MMA(1, 1, At, B1); PG8_BAR;
            PG8_LDB(B0, 1, 0); PG8_SCHED; PG8_LDA(At, 1, 0); PG8_STAGE(PG8_SA(0, 1), a2 + hstep, voffA);
            PG8_WAIT_L(8); PG8_BAR; PG8_WAIT_L(0); PG8_MMA(0, 0, At, B0); PG8_BAR; PG8_SCHED;
            PG8_LDB(B1, 1, 1); PG8_STAGE(PG8_SB(1, 0), b3, voffB);
            PG8_BAR; PG8_WAIT_L(0); PG8_MMA(0, 1, At, B1); PG8_BAR;
            PG8_LDA(At, 1, 1); PG8_STAGE(PG8_SA(1, 0), a3, voffA);
            PG8_BAR; PG8_WAIT_L(0); PG8_MMA(1, 0, At, B0); PG8_BAR; PG8_SCHED;
            PG8_STAGE(PG8_SB(1, 1), b3 + hstep, voffB);
            PG8_WAIT_V(6); PG8_BAR; PG8_MMA(1, 1, At, B1); PG8_BAR;
            }
        }
        }
        if constexpr (ALIGN_EPI) { if (wr == 0) PG8_BAR; }
        if constexpr (!Epi::AFTER_DRAIN) { E(acc, cur, wr, wc, fr, fq);
#if defined(PG8_EPI_REP2)
            asm volatile("" ::: "memory"); E(acc, cur, wr, wc, fr, fq);
#endif
            S.done(cur); }
        if (!has_next) break;
#pragma unroll
        for (int a = 0; a < 2; ++a)
#pragma unroll
            for (int b = 0; b < 2; ++b)
#pragma unroll
                for (int m = 0; m < 4; ++m)
#pragma unroll
                    for (int n = 0; n < 2; ++n) acc[a][b][m][n] = (f32x4){0.f, 0.f, 0.f, 0.f};
        cur = nxt; cA = nA; cB = nB; ++ui;
        if constexpr (ALIGN_EPI) { if (wr == 1) PG8_BAR; }
    }
    PG8_WAIT_V(0);
    if constexpr (!ALIGN_EPI) { if (wr == 0) PG8_BAR; }
    PG8_BAR;
    if constexpr (Epi::AFTER_DRAIN) { E.fused(acc, cur, wr, wc, fr, fq, lds, wid, lane); S.done(cur); }
#undef PG8_SA
#undef PG8_SB
#undef PG8_STAGE
#undef PG8_LDA
#undef PG8_LDB
#undef PG8_MMA
#undef PG8_WAIT_V
#undef PG8_WAIT_L
#undef PG8_BAR
#undef PG8_SCHED
}
}
constexpr int BATCH = 4, SEQ = 4096, DM = 2048, MTOK = BATCH * SEQ, FF = 5632, NIN = 11264, HW = 1024, NH = 8, HD = 128, DEPTH = 2, NSUB = 3;
constexpr int NMOD = NSUB * 3 * DM;
constexpr float DN_ALPHA = 1.4142135623730951f;
constexpr float LN_EPS = 1e-5f, RMS_EPS = 1e-6f, F_MIN = 1e-30f;
constexpr float ATT_C2 = 0.08838834764831845f * 1.4426950408889634f;
constexpr int MB_BLOCK = 256, MB_NB = SEQ / MB_BLOCK, MB_TOPK = 3;
constexpr int NWAVES = 8;

constexpr size_t MiB = 1u << 20;
constexpr size_t WS_CTL = 0, CTL_ZERO_BYTES = 1 * MiB;
constexpr size_t WS_MOD = 1 * MiB;
constexpr size_t WS_MODP = 2 * MiB;
constexpr size_t WS_KMEAN = 12 * MiB;
constexpr size_t WS_SEL = 12 * MiB + 512 * 1024;
constexpr size_t WS_GTOT = 13 * MiB;
constexpr size_t WS_WTS = 16 * MiB, WL_STRIDE = 192 * MiB;
constexpr size_t WO_GU = 0, WO_D = 88 * MiB, WO_IN = 132 * MiB, WO_A = 176 * MiB, WO_B = 180 * MiB, WO_O = 184 * MiB;
constexpr size_t WS_V = 400 * MiB;
constexpr size_t WS_STATS = 14 * MiB;
constexpr size_t WS_H = 464 * MiB;
constexpr size_t WS_R = 528 * MiB;
constexpr size_t R_ACT = 0;
constexpr size_t R_Q = 176 * MiB, R_VV = 208 * MiB, R_SG = 240 * MiB, R_MQ = 272 * MiB, R_MK = 304 * MiB, R_MV = 336 * MiB, R_GA = 368 * MiB, R_GB = 432 * MiB, R_Z = 496 * MiB  ;
constexpr size_t R_SLOC = 560 * MiB;
constexpr size_t R_MVT = 448 * MiB;
constexpr size_t R_T = 384 * MiB;
constexpr size_t R_HO = 512 * MiB;
constexpr size_t WS_END = WS_R + 624 * MiB;
constexpr size_t DO_B = 32 * MiB, DO_Z = 0, DO_SL = 8 * MiB, DO_MVT = 12 * MiB;
constexpr size_t Z_BADD = DO_B - 8 * MiB, SL_BADD = DO_B - 4 * MiB, MVT_BADD = DO_B - 8 * MiB;

constexpr int CW_BAR = 4096;

constexpr int LDS_BYTES = 147456, MISC_OFF = LDS_BYTES - 512;

#define GAS __attribute__((address_space(1)))
#define LAS __attribute__((address_space(3)))
typedef unsigned short bf16;
typedef unsigned v4u __attribute__((ext_vector_type(4)));
typedef unsigned v2u __attribute__((ext_vector_type(2)));
typedef float f32x4 __attribute__((ext_vector_type(4)));
typedef float f32x2 __attribute__((ext_vector_type(2)));
#define LDS_WAIT() asm volatile("s_waitcnt lgkmcnt(0)" ::: "memory")
#define VM_WAIT() asm volatile("s_waitcnt vmcnt(0)" ::: "memory")
__device__ __forceinline__ unsigned f2bf(float f) { unsigned u = __builtin_bit_cast(unsigned, f); return (u + 0x7fffu + ((u >> 16) & 1u)) >> 16; }
__device__ __forceinline__ unsigned pk2(float lo, float hi) { return f2bf(lo) | (f2bf(hi) << 16); }
__device__ __forceinline__ float bf2f(bf16 v) { return __uint_as_float((unsigned)v << 16); }
__device__ __forceinline__ float wave_sum(float v) {
#pragma unroll
    for (int o = 1; o < 64; o <<= 1) v += __shfl_xor(v, o);
    return v;
}
__device__ __forceinline__ float wave_max(float v) {
#pragma unroll
    for (int o = 1; o < 64; o <<= 1) v = fmaxf(v, __shfl_xor(v, o));
    return v;
}
using pg8::silu_f; using pg8::sigm_f;
#define XB_TMO      128
#define XB_XCNT(j)  (256  + 64 * (j))
#define XB_XSUB(j)  (1280 + 64 * (j))
#define XB_XGEN(j)  (2304 + 64 * (j))
#define XB_TOP      3328
#define XB_TOPGEN   3392
#define XCD_BAR_WORDS 3456
#define XB_SPIN_CAP (1u << 18)

__device__ __forceinline__ unsigned xb_ld(unsigned* p)              { return __hip_atomic_load(p, __ATOMIC_RELAXED, __HIP_MEMORY_SCOPE_AGENT); }
__device__ __forceinline__ unsigned xb_add(unsigned* p, unsigned v) { return __hip_atomic_fetch_add(p, v, __ATOMIC_RELAXED, __HIP_MEMORY_SCOPE_AGENT); }
__device__ __forceinline__ unsigned xb_xcc_id() { return (unsigned)__builtin_amdgcn_s_getreg((3 << 11) | 20) & 0xFu; }
#define XB_SPIN(cond, bar) do { unsigned _sp = 0; while (cond) { __builtin_amdgcn_s_sleep(1); \
    if ((++_sp & 255u) == 0u) { if (xb_ld(&(bar)[XB_TMO])) break; if (_sp > XB_SPIN_CAP) { atomicAdd(&(bar)[XB_TMO], 1u); break; } } } } while (0)

struct XcdBarrier {
    unsigned* bar; unsigned x;
    unsigned gsize;
    volatile LAS unsigned* st;
};

__device__ __forceinline__ XcdBarrier xcd_barrier_post(unsigned* bar, volatile LAS unsigned* st, unsigned gsize) {
    XcdBarrier b; b.bar = bar; b.x = xb_xcc_id(); b.st = st; b.gsize = gsize;
    if (threadIdx.x == 0) (void)xb_add(&bar[XB_XCNT(b.x)], 1u);
    return b;
}
__device__ __forceinline__ void xcd_barrier_complete(unsigned* bar, unsigned x, unsigned& nloc, unsigned& nx, unsigned G) {
    unsigned sum, cnt, mine, sp = 0u;
    for (;;) {
        sum = 0u; cnt = 0u; mine = 0u;
#pragma unroll
        for (unsigned j = 0; j < 16; ++j) { const unsigned c = xb_ld(&bar[XB_XCNT(j)]); sum += c; cnt += (c > 0u) ? 1u : 0u; mine = (j == x) ? c : mine; }
        if (sum == G) break;
        __builtin_amdgcn_s_sleep(1);
        if ((++sp & 255u) == 0u) { if (xb_ld(&bar[XB_TMO])) break; if (sp > XB_SPIN_CAP) { atomicAdd(&bar[XB_TMO], 1u); break; } }
    }
    nloc = mine > 0u ? mine : 1u; nx = cnt > 0u ? cnt : 1u;
}

__device__ __forceinline__ void xcd_barrier(const XcdBarrier& b) {
    asm volatile("s_waitcnt vmcnt(0)" ::: "memory");
    __syncthreads();
    if (threadIdx.x == 0) {
        unsigned* bar = b.bar;
        __builtin_amdgcn_s_waitcnt(0);
        unsigned nloc = b.st[0], nx = b.st[1];
        if (nloc == 0u) { xcd_barrier_complete(bar, b.x, nloc, nx, b.gsize); b.st[0] = nloc; b.st[1] = nx; }
        const unsigned old = xb_add(&bar[XB_XSUB(b.x)], 1u);
        const unsigned gen = old / nloc;
        if (old + 1u == (gen + 1u) * nloc) {
            __builtin_amdgcn_fence(__ATOMIC_RELEASE, "agent");
            asm volatile("s_waitcnt vmcnt(0)" ::: "memory");
            const unsigned og = xb_add(&bar[XB_TOP], 1u);
            const unsigned tg = og / nx;
            if (og + 1u == (tg + 1u) * nx) xb_add(&bar[XB_TOPGEN], 1u);
            else XB_SPIN(xb_ld(&bar[XB_TOPGEN]) == tg, bar);
            __builtin_amdgcn_fence(__ATOMIC_ACQUIRE, "agent");
            xb_add(&bar[XB_XGEN(b.x)], 1u);
            asm volatile("s_waitcnt vmcnt(0)" ::: "memory");
        } else {
            XB_SPIN(xb_ld(&bar[XB_XGEN(b.x)]) == gen, bar);
            __builtin_amdgcn_fence(__ATOMIC_ACQUIRE, "agent");
            asm volatile("s_waitcnt vmcnt(0)" ::: "memory");
        }
    }
    __syncthreads();
}
__device__ __forceinline__ float lower_bound_of(const float* lbl, int l, int col) {
    float m = lbl[col];
#pragma unroll
    for (int j = 1; j < DEPTH; ++j) m = fmaxf(m, lbl[j * HW + col]);
    float den = 0.f, num = 0.f;
#pragma unroll
    for (int j = 0; j < DEPTH; ++j) { const float e = __expf(lbl[j * HW + col] - m); den += e; if (j >= 1 && j <= l) num += e; }
    return num / den;
}

__device__ __forceinline__ void transpose_item64(const float* W, int N, bf16* WT, int ldk, int k0, int n0, int orow0, LAS float* scr, int lane, int kdst = -1, float wscale = 1.f  ) {
    if (kdst < 0) kdst = k0;
    f32x4 v[16];
#pragma unroll
    for (int i = 0; i < 16; ++i) v[i] = __builtin_nontemporal_load((const f32x4*)(W + (size_t)(k0 + 4 * i + (lane >> 4)) * N + n0 + (lane & 15) * 4));
#pragma unroll
    for (int i = 0; i < 16; ++i) { LAS float* s = scr + (4 * i + (lane >> 4)) * 65 + (lane & 15) * 4; s[0] = v[i].x; s[1] = v[i].y; s[2] = v[i].z; s[3] = v[i].w; }
    LDS_WAIT(); asm volatile("" ::: "memory");
    const int c = lane & 7;
#pragma unroll
    for (int j = 0; j < 8; ++j) { const int n = (lane >> 3) + 8 * j; const LAS float* s = scr + (8 * c) * 65 + n;
        v4u o; o.x = pk2(s[0 * 65] * wscale, s[1 * 65] * wscale); o.y = pk2(s[2 * 65] * wscale, s[3 * 65] * wscale); o.z = pk2(s[4 * 65] * wscale, s[5 * 65] * wscale); o.w = pk2(s[6 * 65] * wscale, s[7 * 65] * wscale);
        *(v4u*)(WT + (size_t)(orow0 + n) * ldk + kdst + 8 * c) = o; }
    LDS_WAIT(); asm volatile("" ::: "memory");
}
constexpr int CV_GU = 4 * 2816, CV_D = 2 * 2816, CV_IN = 5632, CV_A = 512, CV_B = 512, CV_O = 1024, CV_LAYER = CV_GU + CV_D + CV_IN + CV_A + CV_B + CV_O;
__device__ __forceinline__ void convert_item(int it, const float* wg, const float* wu, const float* wd, const float* win, const float* wa, const float* wb, const float* wo, unsigned char* wts, LAS float* scr, int lane) {
    const int l = it / CV_LAYER; int r = it % CV_LAYER; unsigned char* wl = wts + (size_t)l * WL_STRIDE;
    if (r < CV_GU) { const int mat = r / 2816, rem = r % 2816, f = mat >> 1, isup = mat & 1, kb = rem / 88, nb = rem % 88, n0 = nb * 64;
        const float* src = (isup ? wu : wg) + (size_t)(l * 2 + f) * DM * FF;
        transpose_item64(src, FF, (bf16*)(wl + WO_GU) + (size_t)f * NIN * DM, DM, kb * 64, n0, 256 * (n0 >> 7) + (n0 & 127) + 128 * isup, scr, lane, -1, isup ? -0.6931471805599453f : -1.4426950408889634f); return; }
    r -= CV_GU;
    if (r < CV_D) { const int f = r / 2816, rem = r % 2816, kb = rem / 32, nb = rem % 32;
        transpose_item64(wd + (size_t)(l * 2 + f) * FF * DM, DM, (bf16*)(wl + WO_D) + (size_t)f * DM * FF, FF, kb * 64, nb * 64, nb * 64, scr, lane); return; }
    r -= CV_D;
    if (r < CV_IN) { const int kb = r / 176, nb = r % 176;
        transpose_item64(win + (size_t)l * DM * NIN, NIN, (bf16*)(wl + WO_IN), DM, kb * 64, nb * 64, nb * 64, scr, lane); return; }
    r -= CV_IN;
    if (r < CV_A) { const int kb = r / 32, nb = r % 32;
        transpose_item64(wa + (size_t)l * HW * DM, DM, (bf16*)(wl + WO_A), 2 * HW, kb * 64, nb * 64, nb * 64, scr, lane); return; }
    r -= CV_A;
    if (r < CV_B) { const int kb = r / 32, nb = r % 32;
        transpose_item64(wb + (size_t)l * HW * DM, DM, (bf16*)(wl + WO_A), 2 * HW, kb * 64, nb * 64, nb * 64, scr, lane, HW + kb * 64); return; }
    r -= CV_B;
    { const int kb = r / 32, nb = r % 32;
        transpose_item64(wo + (size_t)l * DM * DM, DM, (bf16*)(wl + WO_O), DM, kb * 64, nb * 64, nb * 64, scr, lane); }
}
__device__ __forceinline__ void adaln_item(int it, const float* ada_w, float* modp, const LAS float* condT, int lane) {
    const int strip = it % 144, ks = it / 144, l = strip / 72, s = strip % 72;
    const float* wp = ada_w + ((size_t)l * DM + ks * 128) * NMOD + s * 256 + lane * 4;
    f32x4 a0 = {0.f, 0.f, 0.f, 0.f}, a1 = a0, a2 = a0, a3 = a0;
#pragma unroll 16
    for (int k = 0; k < 128; ++k) { const f32x4 w = __builtin_nontemporal_load((const f32x4*)(wp + (size_t)k * NMOD)); const f32x4 cd = *(const LAS f32x4*)(condT + (ks * 128 + k) * 4);
        a0 += w * cd.x; a1 += w * cd.y; a2 += w * cd.z; a3 += w * cd.w; }
    float* o = modp + (size_t)(ks * 4) * (DEPTH * NMOD) + l * NMOD + s * 256 + lane * 4;
    *(f32x4*)(o) = a0; *(f32x4*)(o + DEPTH * NMOD) = a1; *(f32x4*)(o + 2 * DEPTH * NMOD) = a2; *(f32x4*)(o + 3 * DEPTH * NMOD) = a3;
}

__device__ __forceinline__ void modulate_row(const float* xrow, bf16* hrow, const float* shift, const float* scale, int lane) {
#pragma unroll
    for (int j = 0; j < 8; ++j) { const int c = (lane + 64 * j) * 4; const f32x4 x = *(const f32x4*)(xrow + c), sc = *(const f32x4*)(scale + c), sh = *(const f32x4*)(shift + c);
        const f32x4 h = x * (sc + 1.0f) + sh; v2u o; o.x = pk2(h.x, h.y); o.y = pk2(h.z, h.w); *(v2u*)(hrow + c) = o; }
}
using pg8::pk_h2; using pg8::h_lo; using pg8::h_hi;
struct LnRowRegs { float v[4][8]; };
__device__ __forceinline__ void ln_row_load(LnRowRegs& R, const unsigned short* vrow, int lane) {
#pragma unroll
    for (int j = 0; j < 4; ++j) { const v4u w = *(const v4u*)(vrow + (lane + 64 * j) * 8);
        R.v[j][0] = h_lo(w.x); R.v[j][1] = h_hi(w.x); R.v[j][2] = h_lo(w.y); R.v[j][3] = h_hi(w.y); R.v[j][4] = h_lo(w.z); R.v[j][5] = h_hi(w.z); R.v[j][6] = h_lo(w.w); R.v[j][7] = h_hi(w.w); }
}
__device__ __forceinline__ void ln_row_finish(LnRowRegs& R, float* strow  , float* xf, bf16* hrow, const float* g, const float* bta, const float* shift, const float* scale, int lane) {
    float s = 0.f;
#pragma unroll
    for (int j = 0; j < 4; ++j)
#pragma unroll
        for (int i = 0; i < 8; ++i) s += R.v[j][i];
    const float mean = wave_sum(s) * (1.f / DM); float s2 = 0.f;
#pragma unroll
    for (int j = 0; j < 4; ++j)
#pragma unroll
        for (int i = 0; i < 8; ++i) { R.v[j][i] -= mean; s2 += R.v[j][i] * R.v[j][i]; }
    const float rstd = 1.f / sqrtf(wave_sum(s2) * (1.f / DM) + LN_EPS);
    if (strow && lane == 0) { strow[0] = mean; strow[1] = rstd; }
#pragma unroll
    for (int j = 0; j < 4; ++j) { const int c = (lane + 64 * j) * 8; float x[8];
        const f32x4 g0 = *(const f32x4*)(g + c), g1 = *(const f32x4*)(g + c + 4), b0 = *(const f32x4*)(bta + c), b1 = *(const f32x4*)(bta + c + 4);
#pragma unroll
        for (int i = 0; i < 4; ++i) { x[i] = R.v[j][i] * rstd * g0[i] + b0[i]; x[4 + i] = R.v[j][4 + i] * rstd * g1[i] + b1[i]; }
        if (xf) { *(f32x4*)(xf + c) = (f32x4){x[0], x[1], x[2], x[3]}; *(f32x4*)(xf + c + 4) = (f32x4){x[4], x[5], x[6], x[7]}; }
        if (hrow) { const f32x4 s0 = *(const f32x4*)(scale + c), s1 = *(const f32x4*)(scale + c + 4), h0 = *(const f32x4*)(shift + c), h1 = *(const f32x4*)(shift + c + 4); float h[8];
#pragma unroll
            for (int i = 0; i < 4; ++i) { h[i] = x[i] * (s0[i] + 1.0f) + h0[i]; h[4 + i] = x[4 + i] * (s1[i] + 1.0f) + h1[i]; }
            v4u o; o.x = pk2(h[0], h[1]); o.y = pk2(h[2], h[3]); o.z = pk2(h[4], h[5]); o.w = pk2(h[6], h[7]); *(v4u*)(hrow + c) = o; } }
}

__device__ __forceinline__ void ln_row_finish_pc(LnRowRegs& R, float* strow  , float* xf, bf16* hrow, const f32x4 (&Gp)[4][2], const f32x4 (&Bp)[4][2], int lane) {
    float s = 0.f;
#pragma unroll
    for (int j = 0; j < 4; ++j)
#pragma unroll
        for (int i = 0; i < 8; ++i) s += R.v[j][i];
    const float mean = wave_sum(s) * (1.f / DM); float s2 = 0.f;
#pragma unroll
    for (int j = 0; j < 4; ++j)
#pragma unroll
        for (int i = 0; i < 8; ++i) { R.v[j][i] -= mean; s2 += R.v[j][i] * R.v[j][i]; }
    const float rstd = 1.f / sqrtf(wave_sum(s2) * (1.f / DM) + LN_EPS);
    if (strow && lane == 0) { strow[0] = mean; strow[1] = rstd; }
#pragma unroll
    for (int j = 0; j < 4; ++j) { const int c = (lane + 64 * j) * 8; float x[8];
#pragma unroll
        for (int i = 0; i < 4; ++i) { x[i] = R.v[j][i] * rstd * Gp[j][0][i] + Bp[j][0][i]; x[4 + i] = R.v[j][4 + i] * rstd * Gp[j][1][i] + Bp[j][1][i]; }
        if (xf) { *(f32x4*)(xf + c) = (f32x4){x[0], x[1], x[2], x[3]}; *(f32x4*)(xf + c + 4) = (f32x4){x[4], x[5], x[6], x[7]}; }
        if (hrow) { v4u o; o.x = pk2(x[0], x[1]); o.y = pk2(x[2], x[3]); o.z = pk2(x[4], x[5]); o.w = pk2(x[6], x[7]); *(v4u*)(hrow + c) = o; } }
}

typedef short bf16x8 __attribute__((ext_vector_type(8)));
typedef float f32x16 __attribute__((ext_vector_type(16)));
#define MFMA16(a, b, c) __builtin_amdgcn_mfma_f32_16x16x32_bf16((a), (b), (c), 0, 0, 0)
#define MFMA32(a, b, c) __builtin_amdgcn_mfma_f32_32x32x16_bf16((a), (b), (c), 0, 0, 0)
__device__ __forceinline__ unsigned cvtpk(float lo, float hi) { unsigned r; asm volatile("v_cvt_pk_bf16_f32 %0, %1, %2" : "=v"(r) : "v"(lo), "v"(hi)); return r; }
__device__ __forceinline__ bf16x8 pack8(f32x4 a, f32x4 b) { v4u w; w.x = cvtpk(a[0], a[1]); w.y = cvtpk(a[2], a[3]); w.z = cvtpk(b[0], b[1]); w.w = cvtpk(b[2], b[3]); return __builtin_bit_cast(bf16x8, w); }
__device__ __forceinline__ int perm32i(int i) { return 8 * ((i >> 2) & 3) + 4 * (i >> 4) + (i & 3); }

constexpr int HG_T = 128, HG_NU = SEQ / HG_T  , HG_NU5 = HG_NU / 4  , HG_PITCH = 272  , HG_ARR = 128 * HG_PITCH;
constexpr float LOG2E = 1.4426950408889634f;

__device__ __forceinline__ void hg_gate(float z, float lb, float oml, float& k, float& lf2) {
    const float e = __builtin_amdgcn_exp2f(-LOG2E * fmaxf(z, -80.f)), s = __builtin_amdgcn_rcpf(1.f + e);
    k = oml * (e * s); lf2 = __builtin_amdgcn_logf(fmaxf(lb + oml * s, F_MIN));
}
__device__ __forceinline__ void hg_write_row32(LAS unsigned char* rowp  , const float (&v)[32]) {
#pragma unroll
    for (int g = 0; g < 4; ++g) { v4u w; w.x = cvtpk(v[4 * g], v[4 * g + 1]); w.y = cvtpk(v[4 * g + 2], v[4 * g + 3]); w.z = cvtpk(v[16 + 4 * g], v[16 + 4 * g + 1]); w.w = cvtpk(v[16 + 4 * g + 2], v[16 + 4 * g + 3]);
        *(LAS v4u*)(rowp + g * 16) = w; }
}

__device__ __forceinline__ int lane_id_local() { int l; asm volatile("v_mbcnt_lo_u32_b32 %0, -1, 0\n\tv_mbcnt_hi_u32_b32 %0, -1, %0" : "=v"(l)); return l; }
struct HgIn { unsigned z[16], q[16], v[16]; };
__device__ __forceinline__ void hg_load(HgIn& I, int unit, const bf16* Q, const unsigned short* Z, const bf16* VV, int wave, int lane, bool with_q) {
    const int bh = unit >> 5, sc = unit & 31, b = bh >> 3, h = bh & 7, c = wave >> 1, col = h * HD + 64 * (wave & 1) + lane;
    const size_t off = ((size_t)b * SEQ + sc * HG_T + 32 * c) * HW + col;
    Z += (size_t)b * (Z_BADD / 2);
#pragma unroll
    for (int s = 0; s < 16; ++s) { I.z[s] = (unsigned)Z[off + (size_t)(2 * s) * HW] | ((unsigned)Z[off + (size_t)(2 * s + 1) * HW] << 16);
        I.v[s] = (unsigned)VV[off + (size_t)(2 * s) * HW] | ((unsigned)VV[off + (size_t)(2 * s + 1) * HW] << 16);
        if (with_q) I.q[s] = (unsigned)Q[off + (size_t)(2 * s) * HW] | ((unsigned)Q[off + (size_t)(2 * s + 1) * HW] << 16); }
}
__device__ __forceinline__ unsigned short hg_get(const unsigned (&a)[16], int s) { return (unsigned short)((s & 1) ? (a[s >> 1] >> 16) : (a[s >> 1] & 0xffffu)); }
struct HgW { v4u z[4], q[4], v[4]; };
__device__ __forceinline__ void hg_loadw(HgW& W, int unit, const bf16* Q, const unsigned short* Z, const bf16* VV, int wave, int lane, bool with_q) {
    const int bh = unit >> 5, sc = unit & 31, b = bh >> 3, h = bh & 7, tid = wave * 64 + lane;
    Z += (size_t)b * (Z_BADD / 2);
    const size_t base = ((size_t)b * SEQ + sc * HG_T) * HW + h * HD;
#pragma unroll
    for (int k = 0; k < 4; ++k) { const int p = tid + 512 * k; const size_t o = base + (size_t)(p >> 4) * HW + (p & 15) * 8;
        W.z[k] = *(const v4u*)(Z + o); W.v[k] = *(const v4u*)(VV + o); if (with_q) W.q[k] = *(const v4u*)(Q + o); }
}
template <bool BAR2> __device__ __forceinline__ void hg_unstage(HgIn& I, const HgW& W, LAS unsigned char* lds, int wave, int lane, bool with_q) {
    const int tid = wave * 64 + lane;
#pragma unroll
    for (int k = 0; k < 4; ++k) { const int p = tid + 512 * k, o = (p >> 4) * HG_PITCH + (p & 15) * 16;
        *(LAS v4u*)(lds + o) = W.z[k]; *(LAS v4u*)(lds + HG_ARR + o) = W.v[k]; if (with_q) *(LAS v4u*)(lds + 2 * HG_ARR + o) = W.q[k]; }
    LDS_WAIT(); __syncthreads();
    const int c = wave >> 1, d = 64 * (wave & 1) + lane;
#pragma unroll
    for (int s = 0; s < 16; ++s) { const int o0 = (32 * c + 2 * s) * HG_PITCH + d * 2, o1 = o0 + HG_PITCH;
        I.z[s] = (unsigned)*(const LAS unsigned short*)(lds + o0) | ((unsigned)*(const LAS unsigned short*)(lds + o1) << 16);
        I.v[s] = (unsigned)*(const LAS unsigned short*)(lds + HG_ARR + o0) | ((unsigned)*(const LAS unsigned short*)(lds + HG_ARR + o1) << 16);
        if (with_q) I.q[s] = (unsigned)*(const LAS unsigned short*)(lds + 2 * HG_ARR + o0) | ((unsigned)*(const LAS unsigned short*)(lds + 2 * HG_ARR + o1) << 16); }
    if (BAR2) { LDS_WAIT(); __syncthreads(); }
}
__device__ __forceinline__ void hgrnA_unit(HgW& W, int nxt, int unit, const unsigned short* Z, const bf16* VV, const float* lbl, int l, f32x4 (&SA)[8], float& gsum, bool last_sub, int unit5, float* SLOC, float* GTOT, LAS unsigned char* lds, int wave, int lane_) {
    const int lane = lane_id_local();
    const int bh = unit >> 5, sc = unit & 31, b = bh >> 3, h = bh & 7;
    const int c = wave >> 1, d = 64 * (wave & 1) + lane, col = h * HD + d;
    const float lb = lower_bound_of(lbl, l, col), oml = 1.f - lb;
    HgIn I; hg_unstage<false>(I, W, lds + 2 * HG_ARR + 4096, wave, lane, false);
    const size_t row0 = (size_t)b * SEQ + sc * HG_T;
    LAS unsigned char* KT = lds; LAS unsigned char* VT = lds + HG_ARR; LAS float* TOT = (LAS float*)(lds + 2 * HG_ARR); LAS float* GS = TOT + 512;
    float cs[32], kk[32]; float run = 0.f;
    {
#pragma unroll
      for (int s = 0; s < 32; ++s) { float lf2; hg_gate((float)__builtin_bit_cast(_Float16, hg_get(I.z, s)), lb, oml, kk[s], lf2); run += lf2; cs[s] = run; } }
    TOT[c * 128 + d] = run;
    { float vv[32];
#pragma unroll
      for (int s = 0; s < 32; ++s) vv[s] = bf2f(hg_get(I.v, s));
      hg_write_row32(VT + d * HG_PITCH + 64 * c, vv); }
    if (nxt >= 0) hg_loadw(W, nxt, nullptr, Z, VV, wave, lane, false);
    LDS_WAIT(); __syncthreads();
    float suf = 0.f, tot = 0.f;
#pragma unroll
    for (int cc = 0; cc < 4; ++cc) { const float t = TOT[cc * 128 + d]; tot += t; if (cc > c) suf += t; }
#pragma unroll
    for (int s = 0; s < 32; ++s) kk[s] *= __builtin_amdgcn_exp2f(suf + run - cs[s]);
    hg_write_row32(KT + d * HG_PITCH + 64 * c, kk);
    if (c == 0) GS[d] = __builtin_amdgcn_exp2f(tot);
    gsum += tot;
    LDS_WAIT(); __syncthreads();
    const int g = lane >> 4, li = lane & 15;
    f32x4 acc[8];
#pragma unroll
    for (int a = 0; a < 8; ++a) acc[a] = (f32x4){0.f, 0.f, 0.f, 0.f};
#pragma unroll
    for (int ks = 0; ks < 4; ++ks) { const bf16x8 bfr = *(const LAS bf16x8*)(VT + (16 * wave + li) * HG_PITCH + (32 * ks + 8 * g) * 2);
#pragma unroll
        for (int a = 0; a < 8; ++a) { const bf16x8 afr = *(const LAS bf16x8*)(KT + (16 * a + li) * HG_PITCH + (32 * ks + 8 * g) * 2); acc[a] = MFMA16(afr, bfr, acc[a]); } }
#pragma unroll
    for (int a = 0; a < 8; ++a) { const f32x4 gv = *(const LAS f32x4*)(GS + 16 * a + 4 * g); SA[a] = SA[a] * gv + acc[a]; }
    if (last_sub) { float* so = SLOC + (size_t)unit5 * 16384 + (size_t)(unit5 >> 6) * (SL_BADD / 4) + (size_t)wave * 2048 + 4 * lane;
#pragma unroll
        for (int a = 0; a < 8; ++a) *(f32x4*)(so + a * 256) = SA[a];
        if (c == 0) GTOT[(size_t)unit5 * 128 + d] = __builtin_amdgcn_exp2f(gsum); }
    LDS_WAIT(); __syncthreads();
}
__device__ __forceinline__ void hgrnC_unit(HgW& W, int nxt, int unit, const bf16* Q, const unsigned short* Z, const bf16* VV, const bf16* SG, const float* ng  , const float* lbl, int l, f32x4 (&S)[8]  , bf16* HO, LAS unsigned char* lds, int wave, int lane_) {
    const int lane = lane_id_local();
    const int bh = unit >> 5, sc = unit & 31, b = bh >> 3, h = bh & 7;
    const float lb = lower_bound_of(lbl, l, h * HD + 64 * (wave & 1) + lane), oml = 1.f - lb;
    HgIn I; hg_unstage<true>(I, W, lds, wave, lane, true);
    const size_t row0 = (size_t)b * SEQ + sc * HG_T;
    LAS unsigned char* QT = lds; LAS unsigned char* KTt = lds + HG_ARR; LAS unsigned char* KPT = lds + 2 * HG_ARR; LAS unsigned char* VT = lds + 3 * HG_ARR;
    LAS float* GB = (LAS float*)(lds + 4 * HG_ARR); LAS float* RED = (LAS float*)(lds + 4 * HG_ARR + 2048);
    { const int c = wave >> 1, d = 64 * (wave & 1) + lane, pd = (d & ~31) + perm32i(d & 31);
      float bs[32], kk[32]; float run = 0.f;
#pragma unroll
      for (int s = 0; s < 32; ++s) { float lf2; hg_gate((float)__builtin_bit_cast(_Float16, hg_get(I.z, s)), lb, oml, kk[s], lf2); run += lf2; bs[s] = run; }
      GB[c * 128 + d] = __builtin_amdgcn_exp2f(run);
#pragma unroll
      for (int s = 0; s < 32; ++s) { const float qv = bf2f(hg_get(I.q, s));
          *(LAS unsigned short*)(QT + (32 * c + s) * HG_PITCH + pd * 2) = (unsigned short)f2bf(qv * __builtin_amdgcn_exp2f(bs[s]));
          *(LAS unsigned short*)(KTt + (32 * c + s) * HG_PITCH + pd * 2) = (unsigned short)f2bf(kk[s] * __builtin_amdgcn_exp2f(-bs[s])); }
#pragma unroll
      for (int s = 0; s < 32; ++s) kk[s] *= __builtin_amdgcn_exp2f(run - bs[s]);
      hg_write_row32(KPT + d * HG_PITCH + 64 * c, kk);
      float vv[32];
#pragma unroll
      for (int s = 0; s < 32; ++s) vv[s] = bf2f(hg_get(I.v, s));
      hg_write_row32(VT + d * HG_PITCH + 64 * c, vv); }
    if (nxt >= 0) hg_loadw(W, nxt, Q, Z, VV, wave, lane, true);
    LDS_WAIT(); __syncthreads();
    const int g = lane >> 4, li = lane & 15;
    f32x4 oT[4][2];
    v2u sgv[4][2];
#pragma unroll
    for (int c = 0; c < 4; ++c)
#pragma unroll
        for (int ti = 0; ti < 2; ++ti) sgv[c][ti] = *(const v2u*)(SG + (row0 + 32 * c + 16 * ti + li) * HW + h * HD + 16 * wave + 4 * g);
    const f32x4 ngv = *(const f32x4*)(ng + h * HD + 16 * wave + 4 * g);
#pragma unroll
    for (int c = 0; c < 4; ++c) {
        bf16x8 qf[2][4];
#pragma unroll
        for (int ti = 0; ti < 2; ++ti)
#pragma unroll
            for (int ks = 0; ks < 4; ++ks) qf[ti][ks] = *(const LAS bf16x8*)(QT + (32 * c + 16 * ti + li) * HG_PITCH + (32 * ks + 8 * g) * 2);
        f32x4 PT[2][2];
#pragma unroll
        for (int si = 0; si < 2; ++si)
#pragma unroll
            for (int ti = 0; ti < 2; ++ti) PT[si][ti] = (f32x4){0.f, 0.f, 0.f, 0.f};
#pragma unroll
        for (int ks = 0; ks < 4; ++ks)
#pragma unroll
            for (int si = 0; si < 2; ++si) { const bf16x8 kf = *(const LAS bf16x8*)(KTt + (32 * c + 16 * si + li) * HG_PITCH + (32 * ks + 8 * g) * 2);
#pragma unroll
                for (int ti = 0; ti < 2; ++ti) PT[si][ti] = MFMA16(kf, qf[ti][ks], PT[si][ti]); }
#pragma unroll
        for (int si = 0; si < 2; ++si)
#pragma unroll
            for (int ti = 0; ti < 2; ++ti)
#pragma unroll
                for (int r = 0; r < 4; ++r) if (16 * si + 4 * g + r > 16 * ti + li) PT[si][ti][r] = 0.f;
        const bf16x8 vf = *(const LAS bf16x8*)(VT + (16 * wave + li) * HG_PITCH + (32 * c + 8 * g) * 2);
#pragma unroll
        for (int ti = 0; ti < 2; ++ti) {
            f32x4 o = MFMA16(vf, pack8(PT[0][ti], PT[1][ti]), ((f32x4){0.f, 0.f, 0.f, 0.f}));
#pragma unroll
            for (int ks = 0; ks < 4; ++ks) o = MFMA16(pack8(S[2 * ks], S[2 * ks + 1]), qf[ti][ks], o);
            oT[c][ti] = o; }
#pragma unroll
        for (int a = 0; a < 8; ++a) { const f32x4 gv = *(const LAS f32x4*)(GB + c * 128 + 16 * a + 4 * g); S[a] = S[a] * gv;
            const bf16x8 kf = *(const LAS bf16x8*)(KPT + (16 * a + li) * HG_PITCH + (32 * c + 8 * g) * 2); S[a] = MFMA16(kf, vf, S[a]); }
    }
#pragma unroll
    for (int c = 0; c < 4; ++c)
#pragma unroll
        for (int ti = 0; ti < 2; ++ti) { const f32x4 o = oT[c][ti]; float p = (o[0] * o[0] + o[1] * o[1]) + (o[2] * o[2] + o[3] * o[3]); p += __shfl_xor(p, 16); p += __shfl_xor(p, 32);
            if (g == 0) RED[wave * 128 + 32 * c + 16 * ti + li] = p; }
    LDS_WAIT(); __syncthreads();
#pragma unroll
    for (int c = 0; c < 4; ++c)
#pragma unroll
        for (int ti = 0; ti < 2; ++ti) { const int t = 32 * c + 16 * ti + li; float tot = 0.f;
#pragma unroll
            for (int w = 0; w < 8; ++w) tot += RED[w * 128 + t];
            const float rinv = 1.f / sqrtf(tot * (1.f / HD) + RMS_EPS);
            const size_t offo = (row0 + t) * (size_t)(2 * HW) + h * HD + 16 * wave + 4 * g;
            const v2u sg = sgv[c][ti]; const f32x4 o = oT[c][ti];
            v2u w; w.x = pk2(o[0] * rinv * ngv[0] * __uint_as_float(sg.x << 16), o[1] * rinv * ngv[1] * __uint_as_float(sg.x & 0xffff0000u));
            w.y = pk2(o[2] * rinv * ngv[2] * __uint_as_float(sg.y << 16), o[3] * rinv * ngv[3] * __uint_as_float(sg.y & 0xffff0000u));
            *(v2u*)(HO + offo) = w; }
    LDS_WAIT(); __syncthreads();
}

__device__ __forceinline__ void kmean_wg(int it, const bf16* MK, float* KMEAN, LAS float* red, int wave, int lane) {
    const int sub = it * 2 + (wave >> 2), qr = wave & 3, h = sub & 7, n = (sub >> 3) & 15, b = sub >> 7;
    const bf16* p = MK + ((size_t)b * SEQ + n * MB_BLOCK + qr * 64) * HW + h * HD + 2 * lane;
    float s0 = 0.f, s1 = 0.f;
#pragma unroll
    for (int j = 0; j < 64; ++j) { const unsigned w = *(const unsigned*)(p + (size_t)j * HW); s0 += __uint_as_float(w << 16); s1 += __uint_as_float(w & 0xffff0000u); }
    red[wave * 128 + 2 * lane] = s0; red[wave * 128 + 2 * lane + 1] = s1;
    LDS_WAIT(); __syncthreads();
    if (qr == 0) { const int w0 = wave; float a0 = 0.f, a1 = 0.f;
#pragma unroll
        for (int q = 0; q < 4; ++q) { a0 += red[(w0 + q) * 128 + 2 * lane]; a1 += red[(w0 + q) * 128 + 2 * lane + 1]; }
        float* o = KMEAN + (((size_t)(b * NH + h) * MB_NB + n) * HD + 2 * lane); o[0] = a0 * (1.f / MB_BLOCK); o[1] = a1 * (1.f / MB_BLOCK); }
    LDS_WAIT(); __syncthreads();
}
__device__ __forceinline__ void mvt_load(int it, const bf16* MV, v4u (&w)[8], int lane) {
    const int dh = it & 1, tg = (it >> 1) & 63, h = (it >> 7) & 7, b = it >> 10;
    const bf16* src = MV + ((size_t)b * SEQ + tg * 64 + lane) * HW + h * HD + 64 * dh;
#pragma unroll
    for (int c = 0; c < 8; ++c) w[c] = *(const v4u*)(src + 8 * c);
}
__device__ __forceinline__ void mvt_finish(int it, const v4u (&wv)[8], bf16* MVT, LAS unsigned short* tile  , int lane) {
    const int dh = it & 1, tg = (it >> 1) & 63, h = (it >> 7) & 7, b = it >> 10;
    const int i16 = lane & 15, pos = (lane & ~15) + 8 * ((i16 >> 2) & 1) + 4 * (i16 >> 3) + (i16 & 3);
#pragma unroll
    for (int c = 0; c < 8; ++c) { const v4u w = wv[c]; const unsigned ww[4] = {w.x, w.y, w.z, w.w};
#pragma unroll
        for (int j = 0; j < 4; ++j) { tile[(8 * c + 2 * j) * 72 + pos] = (unsigned short)(ww[j] & 0xffffu); tile[(8 * c + 2 * j + 1) * 72 + pos] = (unsigned short)(ww[j] >> 16); } }
    LDS_WAIT(); asm volatile("" ::: "memory");
    bf16* dst = MVT + ((size_t)(b * NH + h) * HD + 64 * dh) * SEQ + (size_t)b * (MVT_BADD / 2) + tg * 64;
#pragma unroll
    for (int j = 0; j < 8; ++j) { const int dd = (lane >> 3) + 8 * j, part = lane & 7; const v4u w = *(const LAS v4u*)(tile + dd * 72 + part * 8); *(v4u*)(dst + (size_t)dd * SEQ + part * 8) = w; }
    LDS_WAIT(); asm volatile("" ::: "memory");
}
__device__ __forceinline__ void sel_item(int idx, const bf16* MQ, const float* KMEAN, unsigned* SEL) {
    const int t = idx & (SEQ - 1), bh = idx >> 12, b = bh >> 3, h = bh & 7, qb = t >> 8;
    const size_t row = (size_t)b * SEQ + t;
    unsigned mask = 0u;
    if (qb > 0) {
        float q[HD];
        const bf16* qp = MQ + row * HW + h * HD;
#pragma unroll
        for (int c = 0; c < 16; ++c) { const v4u w = *(const v4u*)(qp + c * 8);
            q[c * 8 + 0] = __uint_as_float(w.x << 16); q[c * 8 + 1] = __uint_as_float(w.x & 0xffff0000u); q[c * 8 + 2] = __uint_as_float(w.y << 16); q[c * 8 + 3] = __uint_as_float(w.y & 0xffff0000u);
            q[c * 8 + 4] = __uint_as_float(w.z << 16); q[c * 8 + 5] = __uint_as_float(w.z & 0xffff0000u); q[c * 8 + 6] = __uint_as_float(w.w << 16); q[c * 8 + 7] = __uint_as_float(w.w & 0xffff0000u); }
        const float* km = KMEAN + (size_t)(b * NH + h) * MB_NB * HD;
        float g0 = -INFINITY, g1 = -INFINITY, g2 = -INFINITY; int i0 = -1, i1 = -1, i2 = -1;
        for (int n = 0; n < qb; ++n) {
            float s = 0.f;
#pragma unroll
            for (int d = 0; d < HD; ++d) s += q[d] * km[n * HD + d];
            if (s > g0) { g2 = g1; i2 = i1; g1 = g0; i1 = i0; g0 = s; i0 = n; }
            else if (s > g1) { g2 = g1; i2 = i1; g1 = s; i1 = n; }
            else if (s > g2) { g2 = s; i2 = n; }
        }
        if (i0 >= 0) mask |= 1u << i0; if (i1 >= 0) mask |= 1u << i1; if (i2 >= 0) mask |= 1u << i2;
    }
    SEL[row * NH + h] = mask;
}
constexpr int MB_KB = 64 * 272, MB_VB = 128 * 144;
__device__ __forceinline__ void moba_unit(int bh, int qb, bool desc, const bf16* MQ, const bf16* MK, const bf16* MVT, const float* KMEAN, bf16* MO, LAS unsigned char* lds, int wave, int lane) {
    const int b = bh >> 3, h = bh & 7, tid = wave * 64 + lane, ql = lane & 31, hh = lane >> 5;
    const size_t rowq = (size_t)b * SEQ + qb * MB_BLOCK + wave * 32 + ql;
    bf16x8 qf[8];
#pragma unroll
    for (int ks = 0; ks < 8; ++ks) qf[ks] = *(const bf16x8*)(MQ + rowq * HW + h * HD + 16 * ks + 8 * hh);
    LAS unsigned char* KB = lds; LAS unsigned char* VB = lds + 2 * MB_KB;
    const bf16* kbase = MK + (size_t)b * SEQ * HW + h * HD; const bf16* vbase = MVT + (size_t)(b * NH + h) * HD * SEQ + (size_t)b * (MVT_BADD / 2);
    v4u kreg[2], vreg[2];
#define MB_PAST(i) (desc ? qb - 1 - (((i) - 4) >> 2) : (((i) - 4) >> 2))
#define MB_LOAD(i) do { const int blk_ = ((i) < 4) ? qb : MB_PAST(i); const int key0_ = blk_ * MB_BLOCK + ((i) & 3) * 64; \
        _Pragma("unroll") for (int j_ = 0; j_ < 2; ++j_) { const int id_ = tid + 512 * j_; kreg[j_] = *(const v4u*)(kbase + (size_t)(key0_ + (id_ >> 4)) * HW + (id_ & 15) * 8); \
            vreg[j_] = *(const v4u*)(vbase + (size_t)(id_ >> 3) * SEQ + key0_ + (id_ & 7) * 8); } } while (0)
#define MB_STORE(buf) do { _Pragma("unroll") for (int j_ = 0; j_ < 2; ++j_) { const int id_ = tid + 512 * j_; *(LAS v4u*)(KB + (buf) * MB_KB + (id_ >> 4) * 272 + (id_ & 15) * 16) = kreg[j_]; \
            *(LAS v4u*)(VB + (buf) * MB_VB + (id_ >> 3) * 144 + (id_ & 7) * 16) = vreg[j_]; } } while (0)
    MB_LOAD(0);
    unsigned sel = 0u;
    if (qb > 0) {
        LAS float* KM = (LAS float*)(lds + 73728);
        const float* kmg = KMEAN + (size_t)bh * MB_NB * HD;
        for (int i = tid; i < qb * 32; i += 512) *(LAS f32x4*)(KM + i * 4) = *(const f32x4*)(kmg + i * 4);
        LDS_WAIT(); __syncthreads();
        float g0 = -INFINITY, g1 = -INFINITY, g2 = -INFINITY; int i0 = -1, i1 = -1, i2 = -1;
        for (int n = 0; n < qb; ++n) { float sc_ = 0.f;
#pragma unroll
            for (int ks = 0; ks < 8; ++ks) { const f32x4 ka = *(const LAS f32x4*)(KM + n * HD + 16 * ks + 8 * hh), kb = *(const LAS f32x4*)(KM + n * HD + 16 * ks + 8 * hh + 4);
                const v4u w = __builtin_bit_cast(v4u, qf[ks]);
                sc_ += __uint_as_float(w.x << 16) * ka.x + __uint_as_float(w.x & 0xffff0000u) * ka.y + __uint_as_float(w.y << 16) * ka.z + __uint_as_float(w.y & 0xffff0000u) * ka.w
                     + __uint_as_float(w.z << 16) * kb.x + __uint_as_float(w.z & 0xffff0000u) * kb.y + __uint_as_float(w.w << 16) * kb.z + __uint_as_float(w.w & 0xffff0000u) * kb.w; }
            sc_ += __shfl_xor(sc_, 32);
            if (sc_ > g0) { g2 = g1; i2 = i1; g1 = g0; i1 = i0; g0 = sc_; i0 = n; }
            else if (sc_ > g1) { g2 = g1; i2 = i1; g1 = sc_; i1 = n; }
            else if (sc_ > g2) { g2 = sc_; i2 = n; } }
        if (i0 >= 0) sel |= 1u << i0; if (i1 >= 0) sel |= 1u << i1; if (i2 >= 0) sel |= 1u << i2;
    }
    f32x16 O[4];
#pragma unroll
    for (int dt = 0; dt < 4; ++dt)
#pragma unroll
        for (int r = 0; r < 16; ++r) O[dt][r] = 0.f;
    float m_used = 0.f, lsum = 0.f;
    const int nt = 4 * (qb + 1);
    MB_STORE(0); LDS_WAIT(); __syncthreads();
    for (int i = 0; i < nt; ++i) {
        if (i + 1 < nt) MB_LOAD(i + 1);
        const LAS unsigned char* Kc = KB + (i & 1) * MB_KB; const LAS unsigned char* Vc = VB + (i & 1) * MB_VB;
#pragma unroll
        for (int mt = 0; mt < 2; ++mt) {
            if (i < 4 && (i & 3) * 64 + 32 * mt > wave * 32 + 31) continue;
            f32x16 sT;
            { const float c0 = (i < 4 || ((sel >> MB_PAST(i)) & 1u)) ? -m_used : -INFINITY;
#pragma unroll
              for (int r = 0; r < 16; ++r) sT[r] = c0; }
#pragma unroll
            for (int ks = 0; ks < 8; ++ks) { const bf16x8 kf = *(const LAS bf16x8*)(Kc + (32 * mt + ql) * 272 + (16 * ks + 8 * hh) * 2); sT = MFMA32(kf, qf[ks], sT); if ((ks & 3) == 3) asm volatile("" ::: "memory"); }
            if (i < 4) { const int qi = wave * 32 + ql - (i & 3) * 64;
#pragma unroll
                for (int r = 0; r < 16; ++r) if (32 * mt + (r & 3) + 8 * (r >> 2) + 4 * hh > qi) sT[r] = -INFINITY; }
            float rm = sT[0];
#pragma unroll
            for (int r = 1; r < 16; ++r) rm = fmaxf(rm, sT[r]);
            rm = fmaxf(rm, __shfl_xor(rm, 32));
            const bool first = (i == 0 && mt == 0);
            if (first || __any(rm > 8.f)) {
                const float dl = first ? rm : fmaxf(rm, 0.f), al = __builtin_amdgcn_exp2f(-dl); m_used += dl; lsum *= al;
#pragma unroll
                for (int r = 0; r < 16; ++r) sT[r] -= dl;
#pragma unroll
                for (int dt = 0; dt < 4; ++dt)
#pragma unroll
                    for (int r = 0; r < 16; ++r) O[dt][r] *= al; }
#pragma unroll
            for (int r = 0; r < 16; ++r) { const float pe = __builtin_amdgcn_exp2f(sT[r]); sT[r] = pe; lsum += pe; }
            bf16x8 pf[2];
#pragma unroll
            for (int s2 = 0; s2 < 2; ++s2) { v4u w; w.x = cvtpk(sT[8 * s2], sT[8 * s2 + 1]); w.y = cvtpk(sT[8 * s2 + 2], sT[8 * s2 + 3]); w.z = cvtpk(sT[8 * s2 + 4], sT[8 * s2 + 5]); w.w = cvtpk(sT[8 * s2 + 6], sT[8 * s2 + 7]);
                pf[s2] = __builtin_bit_cast(bf16x8, w); }
#pragma unroll
            for (int dt = 0; dt < 4; ++dt) {
#pragma unroll
                for (int s2 = 0; s2 < 2; ++s2) { const bf16x8 vf = *(const LAS bf16x8*)(Vc + (32 * dt + ql) * 144 + (16 * (2 * mt + s2) + 8 * hh) * 2); O[dt] = MFMA32(vf, pf[s2], O[dt]); }
                if (dt & 1) asm volatile("" ::: "memory"); }
        }
        if (i + 1 < nt) MB_STORE((i + 1) & 1);
        LDS_WAIT(); __syncthreads();
    }
#undef MB_LOAD
#undef MB_STORE
#undef MB_PAST
    const float inv = 1.f / (lsum + __shfl_xor(lsum, 32));
    bf16* op = MO + rowq * (size_t)(2 * HW) + h * HD + 4 * hh;
#pragma unroll
    for (int dt = 0; dt < 4; ++dt)
#pragma unroll
        for (int rq = 0; rq < 4; ++rq) { v2u w; w.x = pk2(O[dt][4 * rq] * inv, O[dt][4 * rq + 1] * inv); w.y = pk2(O[dt][4 * rq + 2] * inv, O[dt][4 * rq + 3] * inv); *(v2u*)(op + 32 * dt + 8 * rq) = w; }
}
#ifndef REP_P0
#define REP_P0 1
#endif
#ifndef REP_LN
#define REP_LN 1
#endif
#ifndef REP_GEMM
#define REP_GEMM 1
#endif
#ifndef REP_A
#define REP_A 1
#endif
#ifndef REP_B
#define REP_B 1
#endif
#ifndef REP_MOBA
#define REP_MOBA 1
#endif
#ifndef REP_HC
#define REP_HC 1
#endif
struct Args { const float* in[15]; float* out; unsigned char* ws; int ph_lo, ph_hi; };
#ifndef MK_N_LAUNCHES
#define MK_N_LAUNCHES 1
#endif
constexpr int N_PHASES = 3 + DEPTH * (3 + 6 + 3);

constexpr int CW_CONV = 8192 + 512;
constexpr int CW_PBAR = 16384;
constexpr int CW_GRP = 8192;
struct Pipe { int pg, lw, gp; unsigned* cnt; unsigned* tmo; };
__device__ __forceinline__ Pipe make_pipe(unsigned* ctl) { Pipe P; const int G = gridDim.x, c = blockIdx.x;
    P.pg = (c & 7) >> 1; P.lw = (c >> 3) * 2 + (c & 1); P.gp = G >> 2;
    P.cnt = ctl + CW_GRP + 64 * P.pg; P.tmo = ctl + CW_BAR + XB_TMO; return P; }
__device__ __forceinline__ void grp_barrier(const Pipe& P, unsigned& epoch) {
    asm volatile("s_waitcnt vmcnt(0)" ::: "memory");
    __syncthreads();
    ++epoch;
    if (threadIdx.x == 0) {
        __builtin_amdgcn_fence(__ATOMIC_RELEASE, "agent");
        asm volatile("s_waitcnt vmcnt(0)" ::: "memory");
        (void)__hip_atomic_fetch_add(P.cnt, 1u, __ATOMIC_RELAXED, __HIP_MEMORY_SCOPE_AGENT);
        const unsigned target = epoch * (unsigned)P.gp; unsigned sp = 0;
        while (__hip_atomic_load(P.cnt, __ATOMIC_RELAXED, __HIP_MEMORY_SCOPE_AGENT) < target) { __builtin_amdgcn_s_sleep(1);
            if ((++sp & 255u) == 0u) { if (xb_ld(P.tmo)) break; if (sp > XB_SPIN_CAP) { atomicAdd(P.tmo, 1u); break; } } }
        __builtin_amdgcn_fence(__ATOMIC_ACQUIRE, "agent");
        asm volatile("s_waitcnt vmcnt(0)" ::: "memory");
    }
    __syncthreads();
}
#define ROWX(v) (((((v) >> 3) & 1) << 11) | ((((v) >> 4) << 3) | ((v) & 7)))
#define PH_RUN (lo <= ph && ph < hi)
#ifndef REP_BAR
#define REP_BAR 1
#endif
#define PIPE_HERE const Pipe PP = make_pipe((unsigned*)(args.ws + WS_CTL)); const int pgw = PP.lw * NWAVES + wave, PNGW = PP.gp * NWAVES
#define PH_END do { if (lo <= ph && ph + 1 < hi) { if (ph < 2) xcd_barrier(bar); else xcd_barrier(pbar); } ++ph; } while (0)
template <int l, int sub>
__device__ __forceinline__ void sub_layer(const Args& args, LAS unsigned char* lds, const XcdBarrier& bar, const XcdBarrier& pbar, int lo, int hi, int wave, int lane) {
    const int tid = threadIdx.x; const int G = gridDim.x, gw = blockIdx.x * NWAVES + wave, NGW = G * NWAVES, gt = blockIdx.x * (NWAVES * 64) + tid, NGT = G * NWAVES * 64;
    unsigned char* ws = args.ws; const float* x_in = args.in[0]; const float* ln_g = args.in[4]; const float* ln_b = args.in[5]; const float* lbl = args.in[10]; const float* hg_ng = args.in[11];
    float* STATS = (float*)(ws + WS_STATS); float* MOD = (float*)(ws + WS_MOD); unsigned short* V = (unsigned short*)(ws + WS_V); bf16* H = (bf16*)(ws + WS_H); unsigned char* R = ws + WS_R;
    unsigned char* OUTS = (unsigned char*)args.out;
    unsigned char* wl = ws + WS_WTS + (size_t)l * WL_STRIDE;
    int ph = 3 + l * 12 + (sub == 0 ? 0 : (sub == 1 ? 3 : 9));

            const float* gatev = MOD + (size_t)l * BATCH * NMOD + (sub * 3 + 2) * DM;
            if (sub != 1) {
                const int f = sub >> 1;
                if (PH_RUN) {
                    pg8::Gemm g{H, (const bf16*)(wl + WO_GU) + (size_t)f * NIN * DM, MTOK, NIN, DM}; pg8::RevOrder S; S.init(MTOK, NIN, G, (int)blockIdx.x);
                    pg8::EpiGateUp E{(bf16*)(R + R_ACT), FF};
#ifndef NO_G_GU
                    pg8::gemm_phase<pg8::EpiGateUp, pg8::RevOrder, true, true>(lds, g, S, E);
#endif
                }
                PH_END;
                if (PH_RUN) {
                    pg8::Gemm g{(const bf16*)(R + R_ACT), (const bf16*)(wl + WO_D) + (size_t)f * DM * FF, MTOK, DM, FF}; pg8::StaticOrder S; S.init(MTOK, DM, G, (int)blockIdx.x);
                    constexpr bool XF = (l == 0 && sub == 0); constexpr int pli = XF ? 0 : l * NSUB + sub - 1;
                    typedef pg8::EpiResid<XF, DM, NMOD, SEQ, 1> EpiR; EpiR E{x_in, V, gatev, STATS, ln_g + (size_t)pli * DM, ln_b + (size_t)pli * DM};
#ifndef NO_G_DN
                    pg8::gemm_phase<EpiR, pg8::StaticOrder, true, true>(lds, g, S, E);
#endif
                }
                PH_END;
            } else {
                if (PH_RUN) {
                    if (l == 0) {
                        if (tid == 0) { unsigned* cv = (unsigned*)(args.ws + WS_CTL) + CW_CONV; unsigned* tmo_ = (unsigned*)(args.ws + WS_CTL) + CW_BAR + XB_TMO; unsigned sp = 0;
                            while (__hip_atomic_load(cv, __ATOMIC_RELAXED, __HIP_MEMORY_SCOPE_AGENT) < (unsigned)G) { __builtin_amdgcn_s_sleep(1);
                                if ((++sp & 255u) == 0u) { if (xb_ld(tmo_)) break; if (sp > XB_SPIN_CAP) { atomicAdd(tmo_, 1u); break; } } }
                            __builtin_amdgcn_fence(__ATOMIC_ACQUIRE, "agent"); asm volatile("s_waitcnt vmcnt(0)" ::: "memory"); }
                        __syncthreads(); }
                    pg8::Gemm g{H, (const bf16*)(wl + WO_IN), MTOK, NIN, DM}; pg8::RevOrder S; S.init(MTOK, NIN, G, (int)blockIdx.x);
                    typedef pg8::EpiInProj<R_Q, R_VV, R_SG, R_MQ, R_MK, R_MV, R_GA, R_GB, Z_BADD> EpiIP; EpiIP E{R, OUTS + DO_Z};
#ifndef NO_G_IN
                    pg8::gemm_phase<EpiIP, pg8::RevOrder, true, true>(lds, g, S, E);
#endif
                }
                PH_END;
                if (PH_RUN) { _Pragma("unroll 1") for (int rep_ = 0; rep_ < REP_A; ++rep_) { if (rep_) { VM_WAIT(); __syncthreads(); }
                  PIPE_HERE;
                  { const int bb = PP.pg;
#ifndef NO_HA
                    HgW I; if (PP.lw < NH * HG_NU5) hg_loadw(I, (bb * (NH * HG_NU5) + PP.lw) * 4, nullptr, (const unsigned short*)(OUTS + DO_Z), (const bf16*)(R + R_VV), wave, lane_id_local(), false);
#endif
                    for (int it = PP.lw; it < 64; it += PP.gp) kmean_wg(bb * 64 + it, (const bf16*)(R + R_MK), (float*)(ws + WS_KMEAN), (LAS float*)lds, wave, lane);
                    for (int it = pgw; it < NH * 64 * 2; it += 2 * PNGW) {
                        v4u wA[8], wB[8]; const bool two = it + PNGW < NH * 64 * 2;
                        mvt_load(bb * (NH * 64 * 2) + it, (const bf16*)(R + R_MV), wA, lane); if (two) mvt_load(bb * (NH * 64 * 2) + it + PNGW, (const bf16*)(R + R_MV), wB, lane);
                        mvt_finish(bb * (NH * 64 * 2) + it, wA, (bf16*)(OUTS + DO_MVT), (LAS unsigned short*)(lds + wave * 9216), lane);
                        if (two) mvt_finish(bb * (NH * 64 * 2) + it + PNGW, wB, (bf16*)(OUTS + DO_MVT), (LAS unsigned short*)(lds + wave * 9216), lane); }
                    __syncthreads();
#ifndef NO_HA
                    { const int NUB = NH * HG_NU5  ; int il = PP.lw; const unsigned short* Zp = (const unsigned short*)(OUTS + DO_Z); const bf16* Vp = (const bf16*)(R + R_VV);
#pragma unroll 1
                      for (; il < NUB; il += PP.gp) { const int u5 = bb * NUB + il; f32x4 SA[8]; float gsum = 0.f;
#pragma unroll
                          for (int a_ = 0; a_ < 8; ++a_) SA[a_] = (f32x4){0.f, 0.f, 0.f, 0.f};
#pragma unroll 1
                          for (int j = 0; j < 4; ++j) { const int nxt = (j < 3) ? u5 * 4 + j + 1 : ((il + PP.gp < NUB) ? (u5 + PP.gp) * 4 : -1);
                              hgrnA_unit(I, nxt, u5 * 4 + j, Zp, Vp, lbl, l, SA, gsum, j == 3, u5, (float*)(OUTS + DO_SL), (float*)(ws + WS_GTOT), lds, wave, lane); } } }
                  }
#endif
                } }
                PH_END;
                if (PH_RUN) {
                  PIPE_HERE;
                  { const int bb = PP.pg;
                    for (int pl = PP.lw; pl < NH * 8; pl += PP.gp) { const int bh = bb * NH + (pl & 1) * 4 + (pl >> 4), s = (pl >> 1) & 7;
#ifndef NO_MOBA2
#pragma unroll 1
                        for (int j = 0; j < 2 * REP_MOBA; ++j) moba_unit(bh, (j & 1) ? s : 15 - s, (j & 1) != 0, (const bf16*)(R + R_MQ), (const bf16*)(R + R_MK), (const bf16*)(OUTS + DO_MVT), (const float*)(ws + WS_KMEAN), (bf16*)(R + R_SLOC) + HW, lds, wave, lane);
#endif
                    }
#ifndef NO_HC
                    { HgW I; const int NUB = NH * HG_NU5; int il = PP.lw; const bf16* Qp = (const bf16*)(R + R_Q); const unsigned short* Zp = (const unsigned short*)(OUTS + DO_Z); const bf16* Vp = (const bf16*)(R + R_VV);
                      const float* SL5 = (const float*)(OUTS + DO_SL); const float* GT5 = (const float*)(ws + WS_GTOT);
                      if (il < NUB) hg_loadw(I, (bb * NUB + il) * 4, Qp, Zp, Vp, wave, lane, true);
#pragma unroll 1
                      for (; il < NUB; il += PP.gp) { const int u5 = bb * NUB + il, bh5 = u5 >> 3, seg = u5 & 7, g_ = lane >> 4;
                          f32x4 S[8];
#pragma unroll
                          for (int a_ = 0; a_ < 8; ++a_) S[a_] = (f32x4){0.f, 0.f, 0.f, 0.f};
#pragma unroll 1
                          for (int jj = 0; jj < seg; ++jj) { const float* sp = SL5 + (size_t)(bh5 * 8 + jj) * 16384 + (size_t)(bh5 >> 3) * (SL_BADD / 4) + (size_t)wave * 2048 + 4 * lane; const float* gp = GT5 + (size_t)(bh5 * 8 + jj) * 128 + 4 * g_;
#pragma unroll
                              for (int a_ = 0; a_ < 8; ++a_) { const f32x4 gv = *(const f32x4*)(gp + 16 * a_); const f32x4 t_ = *(const f32x4*)(sp + a_ * 256);
                                  S[a_] = S[a_] * gv + t_; } }
#pragma unroll 1
                          for (int j = 0; j < 4; ++j) { const int nxt = (j < 3) ? u5 * 4 + j + 1 : ((il + PP.gp < NUB) ? (u5 + PP.gp) * 4 : -1);
                              hgrnC_unit(I, nxt, u5 * 4 + j, Qp, Zp, Vp, (const bf16*)(R + R_SG), hg_ng + l * HW, lbl, l, S, (bf16*)(R + R_SLOC), lds, wave, lane); } } }
#endif
                }
                PH_END;
                if (PH_RUN) {
                    { pg8::Gemm g{(const bf16*)(R + R_SLOC), (const bf16*)(wl + WO_A), MTOK, DM, 2 * HW}; pg8::StaticOrder S; S.init(MTOK, DM, G, (int)blockIdx.x);
                      pg8::EpiMerge E{(const bf16*)(R + R_GA), (const bf16*)(R + R_GB), (bf16*)(R + R_Z), DM};
                      pg8::gemm_phase<pg8::EpiMerge, pg8::StaticOrder, true, true>(lds, g, S, E);
                    }
                }
                PH_END;
                if (PH_RUN) {
                    pg8::Gemm g{(const bf16*)(R + R_Z), (const bf16*)(wl + WO_O), MTOK, DM, DM}; pg8::StaticOrder S; S.init(MTOK, DM, G, (int)blockIdx.x);
                    constexpr int pli = l * NSUB + sub - 1; typedef pg8::EpiResid<false, DM, NMOD, SEQ, 0> EpiR; EpiR E{x_in, V, gatev, STATS, ln_g + (size_t)pli * DM, ln_b + (size_t)pli * DM};
#ifndef NO_G_OUT
                    pg8::gemm_phase<EpiR, pg8::StaticOrder, true, true>(lds, g, S, E);
#endif
                  }
                }
                PH_END;
            }
            if (PH_RUN) { _Pragma("unroll 1") for (int rep_ = 0; rep_ < REP_LN; ++rep_) { if (rep_) { VM_WAIT(); __syncthreads(); }
                const bool last = (l == DEPTH - 1 && sub == NSUB - 1);
                const int nl = (sub == NSUB - 1) ? l + 1 : l, nsub = (sub == NSUB - 1) ? 0 : sub + 1;
                const float* g_ = ln_g + (size_t)(l * NSUB + sub) * DM; const float* b_ = ln_b + (size_t)(l * NSUB + sub) * DM;
                PIPE_HERE;
                const int bb = PP.pg;
                const float* md = last ? MOD : MOD + ((size_t)nl * BATCH + bb) * NMOD + (nsub * 3) * DM;
                f32x4 Gp[4][2], Bp[4][2];
#pragma unroll
                for (int j = 0; j < 4; ++j)
#pragma unroll
                    for (int e = 0; e < 2; ++e) { const int c = (lane + 64 * j) * 8 + 4 * e; const f32x4 gg = *(const f32x4*)(g_ + c), bbv = *(const f32x4*)(b_ + c);
                        if (last) { Gp[j][e] = gg; Bp[j][e] = bbv; }
                        else { const f32x4 sc1 = *(const f32x4*)(md + DM + c) + 1.0f, sh = *(const f32x4*)(md + c); Gp[j][e] = gg * sc1; Bp[j][e] = bbv * sc1 + sh; } }
                for (int m_ = pgw; m_ < SEQ; m_ += 4 * PNGW) {
                    LnRowRegs RR[4];
#pragma unroll
                    for (int q_ = 0; q_ < 4; ++q_) if (m_ + q_ * PNGW < SEQ) ln_row_load(RR[q_], V + (size_t)(bb * SEQ + ROWX(m_ + q_ * PNGW)) * DM, lane);
#pragma unroll
                    for (int q_ = 0; q_ < 4; ++q_) if (m_ + q_ * PNGW < SEQ) { const int m = bb * SEQ + ROWX(m_ + q_ * PNGW);
                        ln_row_finish_pc(RR[q_], last ? (float*)nullptr : STATS + 2 * (size_t)m, last ? args.out + (size_t)m * DM : (float*)nullptr, last ? (bf16*)nullptr : H + (size_t)m * DM, Gp, Bp, lane); } }
            } }
            PH_END;

}
__global__ void __launch_bounds__(NWAVES * 64, 2) fwd_kernel(Args args) {
    extern __shared__ __attribute__((aligned(16))) unsigned char lds_raw[];
    LAS unsigned char* lds = (LAS unsigned char*)lds_raw;
    volatile LAS unsigned* MISC = (volatile LAS unsigned*)(lds + MISC_OFF);
    const int tid = threadIdx.x, lane = tid & 63, wave = __builtin_amdgcn_readfirstlane(tid >> 6);
    const int G = gridDim.x, gw = blockIdx.x * NWAVES + wave, NGW = G * NWAVES, gt = blockIdx.x * (NWAVES * 64) + tid, NGT = G * NWAVES * 64;
    unsigned char* ws = args.ws;
    for (int u = tid; u < 128; u += NWAVES * 64) MISC[u] = 0u;
    __syncthreads();
    const int lo = args.ph_lo, hi = args.ph_hi;
    XcdBarrier bar; bar.bar = (unsigned*)(ws + WS_CTL) + CW_BAR; bar.x = 0; bar.st = nullptr; bar.gsize = gridDim.x;
    XcdBarrier pbar = bar;
    if (hi - lo > 1) { bar = xcd_barrier_post((unsigned*)(ws + WS_CTL) + CW_BAR, MISC + 8, gridDim.x);
        pbar = xcd_barrier_post((unsigned*)(ws + WS_CTL) + CW_PBAR + 4096 * (((int)blockIdx.x & 7) >> 1), MISC + 10, gridDim.x >> 2); }
    int ph = 0;

    const float* x_in = args.in[0]; const float* c_in = args.in[1]; const float* ada_w = args.in[2]; const float* ada_b = args.in[3];
    const float* ln_g = args.in[4]; const float* ln_b = args.in[5]; const float* lbl = args.in[10]; const float* hg_ng = args.in[11];
    float* X = args.out;
    float* MOD = (float*)(ws + WS_MOD); float* MODP = (float*)(ws + WS_MODP);
    float* V = (float*)(ws + WS_V); bf16* H = (bf16*)(ws + WS_H);
    unsigned char* R = ws + WS_R;

    if (PH_RUN) { _Pragma("unroll 1") for (int rep_ = 0; rep_ < REP_P0; ++rep_) { if (rep_) { VM_WAIT(); __syncthreads(); }
        LAS float* condT = (LAS float*)lds;
        for (int i = tid; i < BATCH * DM; i += NWAVES * 64) { const int b = i / DM, k = i % DM; condT[k * 4 + b] = silu_f(c_in[i]); }
        __syncthreads();
        for (int it = gw; it < 144 * 16; it += NGW) adaln_item(it, ada_w, MODP, condT, lane);
        __syncthreads();
        LAS float* scr = (LAS float*)(lds + wave * 16640);
        for (int it = gw; it < 5632 + 2816; it += NGW) { const int r = it < 5632 ? it : it - 5632 + CV_GU;
            convert_item(r, args.in[6], args.in[7], args.in[8], args.in[9], args.in[12], args.in[13], args.in[14], ws + WS_WTS, scr, lane); }
    } }
    PH_END;
    if (PH_RUN) { _Pragma("unroll 1") for (int rep_ = 0; rep_ < REP_LN; ++rep_) { if (rep_) { VM_WAIT(); __syncthreads(); }
        for (int i = gt; i < DEPTH * BATCH * NMOD; i += NGT) { const int j = i % NMOD, lb_ = i / NMOD, b = lb_ % BATCH, l = lb_ / BATCH;
            float s = ada_b[l * NMOD + j];
#pragma unroll
            for (int ks = 0; ks < 16; ++ks) s += MODP[(size_t)(ks * 4 + b) * (DEPTH * NMOD) + l * NMOD + j];
            MOD[i] = s; }
    } }
    PH_END;
    if (PH_RUN) { _Pragma("unroll 1") for (int rep_ = 0; rep_ < REP_LN; ++rep_) { if (rep_) { VM_WAIT(); __syncthreads(); }
        PIPE_HERE;
        {
            constexpr int NA = CV_IN + CV_A + CV_B + CV_O  , NB_ = 5632, NC_ = 2816, NREST = NA + NB_ + NC_ + CV_LAYER;
            const int lo_[5] = {0, (NREST * 19) / 100, (NREST * 42) / 100, (NREST * 69) / 100, NREST};
            const int r0 = PP.pg == 0 ? lo_[0] : PP.pg == 1 ? lo_[1] : PP.pg == 2 ? lo_[2] : lo_[3], r1 = PP.pg == 0 ? lo_[1] : PP.pg == 1 ? lo_[2] : PP.pg == 2 ? lo_[3] : lo_[4];
            LAS float* scr = (LAS float*)(lds + wave * 16640);
            for (int r = r0 + pgw; r < r1; r += PNGW) { int it;
                if (r < NA) it = CV_GU + CV_D + r; else if (r < NA + NB_) it = 5632 + (r - NA); else if (r < NA + NB_ + NC_) it = CV_GU + 2816 + (r - NA - NB_); else it = CV_LAYER + (r - NA - NB_ - NC_);
                convert_item(it, args.in[6], args.in[7], args.in[8], args.in[9], args.in[12], args.in[13], args.in[14], ws + WS_WTS, scr, lane); }
            asm volatile("s_waitcnt vmcnt(0)" ::: "memory"); __syncthreads();
            if (tid == 0) { __builtin_amdgcn_fence(__ATOMIC_RELEASE, "agent"); asm volatile("s_waitcnt vmcnt(0)" ::: "memory");
                (void)__hip_atomic_fetch_add((unsigned*)(ws + WS_CTL) + CW_CONV, 1u, __ATOMIC_RELAXED, __HIP_MEMORY_SCOPE_AGENT); }
        }
        const int bb = PP.pg; const float* md = MOD + (size_t)bb * NMOD;
        f32x4 sc1[8], shv[8];
#pragma unroll
        for (int j = 0; j < 8; ++j) { const int c = (lane + 64 * (j >> 1)) * 8 + 4 * (j & 1); sc1[j] = *(const f32x4*)(md + DM + c) + 1.0f; shv[j] = *(const f32x4*)(md + c); }
        for (int m_ = pgw; m_ < SEQ; m_ += 4 * PNGW) {
            f32x4 xr[4][8];
#pragma unroll
            for (int q_ = 0; q_ < 4; ++q_) if (m_ + q_ * PNGW < SEQ) {
#pragma unroll
                for (int j = 0; j < 8; ++j) xr[q_][j] = *(const f32x4*)(x_in + (size_t)(bb * SEQ + ROWX(m_ + q_ * PNGW)) * DM + (lane + 64 * (j >> 1)) * 8 + 4 * (j & 1)); }
#pragma unroll
            for (int q_ = 0; q_ < 4; ++q_) if (m_ + q_ * PNGW < SEQ) { bf16* hrow = H + (size_t)(bb * SEQ + ROWX(m_ + q_ * PNGW)) * DM;
#pragma unroll
                for (int j = 0; j < 4; ++j) { const int c = (lane + 64 * j) * 8;
                    const f32x4 h0 = xr[q_][2 * j] * sc1[2 * j] + shv[2 * j], h1 = xr[q_][2 * j + 1] * sc1[2 * j + 1] + shv[2 * j + 1];
                    v4u o; o.x = pk2(h0.x, h0.y); o.y = pk2(h0.z, h0.w); o.z = pk2(h1.x, h1.y); o.w = pk2(h1.z, h1.w); *(v4u*)(hrow + c) = o; } } }
    } }
    PH_END;

    sub_layer<0, 0>(args, lds, bar, pbar, lo, hi, wave, lane); sub_layer<0, 1>(args, lds, bar, pbar, lo, hi, wave, lane); sub_layer<0, 2>(args, lds, bar, pbar, lo, hi, wave, lane);
    sub_layer<1, 0>(args, lds, bar, pbar, lo, hi, wave, lane); sub_layer<1, 1>(args, lds, bar, pbar, lo, hi, wave, lane); sub_layer<1, 2>(args, lds, bar, pbar, lo, hi, wave, lane);
#undef PH_RUN
#undef PH_END
}

extern "C" void kernel_launch(void* const* d_in, const int* in_sizes, int n_in, void* d_out, int out_size, void* d_ws, size_t ws_size, hipStream_t stream) {
    static int grid = 0;
    if (grid == 0) {
        if (n_in != 15 || in_sizes[0] != MTOK * DM || out_size != MTOK * DM || ws_size < WS_END) { fprintf(stderr, "kernel_launch: unexpected shapes / workspace (n_in %d, ws %zu < %zu); nothing launched\n", n_in, ws_size, (size_t)WS_END); grid = -1; return; }
        int dev = 0, cus = 0, per_cu = 0;
        if (hipGetDevice(&dev) != hipSuccess || hipDeviceGetAttribute(&cus, hipDeviceAttributeMultiprocessorCount, dev) != hipSuccess) { grid = -1; return; }
        if (hipFuncSetAttribute((const void*)fwd_kernel, hipFuncAttributeMaxDynamicSharedMemorySize, LDS_BYTES) != hipSuccess) { fprintf(stderr, "kernel_launch: hipFuncSetAttribute failed\n"); grid = -1; return; }
        if (hipOccupancyMaxActiveBlocksPerMultiprocessor(&per_cu, (const void*)fwd_kernel, NWAVES * 64, LDS_BYTES) != hipSuccess || per_cu < 1) fprintf(stderr, "kernel_launch: occupancy query says %d\n", per_cu);
        (void)hipGetLastError();
        grid = cus - (cus % 8);
    }
    if (grid < 0) return;
    if (hipMemsetAsync((char*)d_ws + WS_CTL, 0, CTL_ZERO_BYTES, stream) != hipSuccess) return;
    Args a{};
    for (int i = 0; i < 15; ++i) a.in[i] = (const float*)d_in[i];
    a.out = (float*)d_out; a.ws = (unsigned char*)d_ws;
#if MK_N_LAUNCHES == 1
    a.ph_lo = 0; a.ph_hi = N_PHASES;
    hipLaunchKernelGGL(fwd_kernel, dim3(grid), dim3(NWAVES * 64), LDS_BYTES, stream, a);
#else
    for (int p = 0; p < N_PHASES; ++p) { a.ph_lo = p; a.ph_hi = p + 1; hipLaunchKernelGGL(fwd_kernel, dim3(grid), dim3(NWAVES * 64), LDS_BYTES, stream, a); }
#endif
}
```

```cpp
#include <hip/hip_runtime.h>
#include <cstdio>
#include <cstdint>
#include <cmath>
#ifndef PG8_UNIT_REP
#define PG8_UNIT_REP 1
#endif
namespace pg8 {
#define PG8_LAS __attribute__((address_space(3)))
typedef unsigned short bf16_t;
typedef short bf16x8 __attribute__((ext_vector_type(8)));
typedef float f32x4 __attribute__((ext_vector_type(4)));
typedef unsigned u32x4 __attribute__((ext_vector_type(4)));
constexpr int BM = 256, BK = 64, HALF = 128, HTB = HALF * BK * 2  , STAGE_BYTES = 8 * HTB, NXCD = 8, WGM = 8;

__host__ __device__ __forceinline__ int lds_byte(int r, int c) { const int st = (r >> 4) * 2 + (c >> 5), rr = r & 15, cc = c & 31, ob = rr * 64 + cc * 2; return st * 1024 + (ob ^ (((ob >> 9) & 1) << 5)); }
__host__ __device__ __forceinline__ void stage_rc(int b, int& R, int& C) { const int st = b / 1024, sb = b % 1024, swz = sb ^ (((sb >> 9) & 1) << 5); R = (st >> 1) * 16 + swz / 64; C = (st & 1) * 32 + (swz % 64) / 2; }
__host__ __device__ __forceinline__ int perm32(int rho) { const int n = rho >> 4, i = rho & 15; return 8 * (i >> 2) + 4 * n + (i & 3); }

struct Unit { int pm, pn; };
struct Gemm { const bf16_t* A; const bf16_t* Bt; int M, N, K; };

struct StaticOrder {
    int nM, nN, nwg, G, c;
    __host__ __device__ void init(int M, int N, int G_, int c_) { nM = M / BM; nN = N / BM; nwg = nM * nN; G = G_; c = c_; }
    __host__ __device__ bool next(int i, Unit& u) const {
        const long L = (long)(i / PG8_UNIT_REP) * G + c; if (L >= nwg) return false;
        int wgid = (int)L; { const int q = nwg / NXCD, r = nwg % NXCD, xcd = wgid % NXCD, off = wgid / NXCD; wgid = (xcd < r ? xcd * (q + 1) : r * (q + 1) + (xcd - r) * q) + off; }
        const int nig = WGM * nN, gid = wgid / nig, fm = gid * WGM, gsz = (nM - fm) < WGM ? (nM - fm) : WGM;
        u.pm = fm + ((wgid % nig) % gsz); u.pn = (wgid % nig) / gsz; return true;
    }
    __device__ __forceinline__ void a_ready(const Unit&) const {}
    __device__ __forceinline__ void done(const Unit&) const {}
};
__device__ __forceinline__ unsigned cvt_pk_bf16(float lo, float hi) { unsigned r; asm volatile("v_cvt_pk_bf16_f32 %0, %1, %2" : "=v"(r) : "v"(lo), "v"(hi)); return r; }
typedef float f32x2 __attribute__((ext_vector_type(2)));
__device__ __forceinline__ float silu_f(float v) { return v * __builtin_amdgcn_rcpf(1.f + __builtin_amdgcn_exp2f(-1.4426950408889634f * v)); }
__device__ __forceinline__ float sigm_f(float v) { return __builtin_amdgcn_rcpf(1.f + __builtin_amdgcn_exp2f(-1.4426950408889634f * v)); }
__device__ __forceinline__ float bf_lo(unsigned w) { return __uint_as_float(w << 16); }
__device__ __forceinline__ float bf_hi(unsigned w) { return __uint_as_float(w & 0xffff0000u); }

typedef _Float16 h2_t __attribute__((ext_vector_type(2)));
__device__ __forceinline__ unsigned pk_h2(float a, float b) { h2_t v = {(_Float16)a, (_Float16)b}; return __builtin_bit_cast(unsigned, v); }
__device__ __forceinline__ float h_lo(unsigned w) { return (float)__builtin_bit_cast(h2_t, w).x; }
__device__ __forceinline__ float h_hi(unsigned w) { return (float)__builtin_bit_cast(h2_t, w).y; }
struct EpiGateUp {
    static constexpr bool PERM = true, AFTER_DRAIN = false; static constexpr int MID_T = -1;
    bf16_t* O; int ldc;
    __device__ __forceinline__ void operator()(const f32x4 (&acc)[2][2][4][2], const Unit& u, int wr, int wc, int fr, int fq) const {
        const int row0 = u.pm * BM + wr * 64 + fr, col0 = u.pn * HALF + wc * 32 + 8 * fq;
#pragma unroll
        for (int ai = 0; ai < 2; ++ai)
#pragma unroll
            for (int m = 0; m < 4; ++m) { bf16_t* rowp = O + (size_t)(row0 + ai * HALF + m * 16) * ldc + col0;
                const f32x4 g0 = acc[ai][0][m][0], g1 = acc[ai][0][m][1], u0 = acc[ai][1][m][0], u1 = acc[ai][1][m][1];
                f32x4 a0, a1;
#pragma unroll
                for (int j = 0; j < 4; ++j) { a0[j] = silu_f(g0[j]) * u0[j]; a1[j] = silu_f(g1[j]) * u1[j]; }
                u32x4 w; w.x = cvt_pk_bf16(a0[0], a0[1]); w.y = cvt_pk_bf16(a0[2], a0[3]); w.z = cvt_pk_bf16(a1[0], a1[1]); w.w = cvt_pk_bf16(a1[2], a1[3]);
                *(u32x4*)rowp = w; }
    }
};

template <size_t oQ, size_t oV, size_t oSG, size_t oMQ, size_t oMK, size_t oMV, size_t oGA, size_t oGB, size_t zbadd> struct EpiInProj {
    static constexpr bool PERM = true, AFTER_DRAIN = false; static constexpr int MID_T = -1;
    static constexpr float qscale = 0.08838834764831845f * 1.4426950408889634f;
    static constexpr size_t oZ = 0;
    unsigned char* R;
    unsigned char* ZB;
    __device__ __forceinline__ void operator()(const f32x4 (&acc)[2][2][4][2], const Unit& u, int wr, int wc, int fr, int fq) const {
        const int row0 = u.pm * BM + wr * 64 + fr; const int pn = u.pn;
        int mode = 0, ld = 1024, ct = pn & 3; size_t off = 0;
        if (pn < 28) { const int t = pn >> 2;
            if (t == 0) { off = oQ; mode = 1; } else if (t == 1) { off = oZ; mode = 3; } else if (t == 2) { off = oV; } else if (t == 3) { off = oSG; mode = 1; }
            else if (t == 4) { off = oMQ; mode = 4; } else if (t == 5) { off = oMK; } else { off = oMV; } }
        else if (pn < 36) { off = oGA; mode = 2; ld = 2048; ct = pn - 28; }
        else { off = oGB; mode = 2; ld = 2048; ct = pn - 36; }
        const int col0 = ct * BM + wc * 32 + 8 * fq;
        if (mode == 3) {
            unsigned short* base = (unsigned short*)(ZB + (size_t)(u.pm >> 4) * zbadd);
#pragma unroll
            for (int ai = 0; ai < 2; ++ai)
#pragma unroll
                for (int m = 0; m < 4; ++m) { unsigned short* rowp = base + (size_t)(row0 + ai * HALF + m * 16) * ld + col0;
#pragma unroll
                    for (int bj = 0; bj < 2; ++bj) { const f32x4 v0 = acc[ai][bj][m][0], v1 = acc[ai][bj][m][1];
                        u32x4 w; w.x = pk_h2(v0[0], v0[1]); w.y = pk_h2(v0[2], v0[3]); w.z = pk_h2(v1[0], v1[1]); w.w = pk_h2(v1[2], v1[3]); *(u32x4*)(rowp + bj * HALF) = w; } }
        } else {
            bf16_t* base = (bf16_t*)(R + off);
#pragma unroll
            for (int ai = 0; ai < 2; ++ai)
#pragma unroll
                for (int m = 0; m < 4; ++m) { bf16_t* rowp = base + (size_t)(row0 + ai * HALF + m * 16) * ld + col0;
#pragma unroll
                    for (int bj = 0; bj < 2; ++bj) { f32x4 v0 = acc[ai][bj][m][0], v1 = acc[ai][bj][m][1];
                        if (mode == 1) {
#pragma unroll
                            for (int j = 0; j < 4; ++j) { v0[j] = silu_f(v0[j]); v1[j] = silu_f(v1[j]); } }
                        else if (mode == 2) {
#pragma unroll
                            for (int j = 0; j < 4; ++j) { v0[j] = sigm_f(v0[j]); v1[j] = sigm_f(v1[j]); } }
                        else if (mode == 4) { v0 = v0 * qscale; v1 = v1 * qscale; }
                        u32x4 w; w.x = cvt_pk_bf16(v0[0], v0[1]); w.y = cvt_pk_bf16(v0[2], v0[3]); w.z = cvt_pk_bf16(v1[0], v1[1]); w.w = cvt_pk_bf16(v1[2], v1[3]);
                        *(u32x4*)(rowp + bj * HALF) = w; } }
        }
    }
};

template <bool XF32, int LDC, int GATE_BSTRIDE, int ROWS_PER_BATCH, int WGT_HALF  > struct EpiResid {
    static constexpr bool PERM = true, AFTER_DRAIN = false; static constexpr int MID_T = -1;
    static constexpr float alpha = 1.4142135623730951f, wgt = WGT_HALF ? 0.5f : 1.0f;
    const float* xf32; unsigned short* out; const float* gate;
    const float* stats; const float* lng; const float* lnb;
    __device__ __forceinline__ void operator()(const f32x4 (&acc)[2][2][4][2], const Unit& u, int wr, int wc, int fr, int fq) const {
        int z_; asm volatile("v_mov_b32 %0, 0" : "=v"(z_));
        const int row0 = u.pm * BM + wr * 64 + (fr + z_), col0 = u.pn * BM + wc * 32 + 8 * (fq + z_);
        const float* gv = gate + (size_t)((u.pm * BM) / ROWS_PER_BATCH) * GATE_BSTRIDE;
        if constexpr (!XF32) {
            f32x2 stA[4], stB[4]; u32x4 xwA[4], xwB[4]; f32x4 gmv[2], lgv[2], lbv[2];
            const unsigned ob = (unsigned)(row0 * LDC + col0) * 2u, sb = (unsigned)row0 * 8u;
#define ER_ROWS(ST, XW, ai_, bj_) do { _Pragma("unroll") for (int m = 0; m < 4; ++m) { \
                ST[m] = *(const f32x2*)((const char*)stats + (sb + (unsigned)(((ai_) * HALF + m * 16) * 8))); XW[m] = *(const u32x4*)((const char*)out + (ob + (unsigned)((((ai_) * HALF + m * 16) * LDC + (bj_) * HALF) * 2))); } } while (0)
#define ER_COLS(bj_) do { _Pragma("unroll") for (int n = 0; n < 2; ++n) { gmv[n] = (*(const f32x4*)(gv + col0 + (bj_) * HALF + n * 4) + 1.0f) * wgt; \
                lgv[n] = *(const f32x4*)(lng + col0 + (bj_) * HALF + n * 4) * alpha; lbv[n] = *(const f32x4*)(lnb + col0 + (bj_) * HALF + n * 4) * alpha; } } while (0)
#define ER_DO(ST, XW, ai_, bj_) do { _Pragma("unroll") for (int m = 0; m < 4; ++m) { const u32x4 w = XW[m]; \
                f32x4 x0 = (f32x4){h_lo(w.x), h_hi(w.x), h_lo(w.y), h_hi(w.y)}, x1 = (f32x4){h_lo(w.z), h_hi(w.z), h_lo(w.w), h_hi(w.w)}; \
                x0 = (x0 - ST[m].x) * ST[m].y * lgv[0] + lbv[0]; x1 = (x1 - ST[m].x) * ST[m].y * lgv[1] + lbv[1]; \
                const f32x4 v0 = x0 + gmv[0] * acc[ai_][bj_][m][0], v1 = x1 + gmv[1] * acc[ai_][bj_][m][1]; \
                u32x4 o; o.x = pk_h2(v0[0], v0[1]); o.y = pk_h2(v0[2], v0[3]); o.z = pk_h2(v1[0], v1[1]); o.w = pk_h2(v1[2], v1[3]); \
                *(u32x4*)((char*)out + (ob + (unsigned)((((ai_) * HALF + m * 16) * LDC + (bj_) * HALF) * 2))) = o; } } while (0)
            ER_COLS(0); ER_ROWS(stA, xwA, 0, 0);
            ER_ROWS(stB, xwB, 1, 0); ER_DO(stA, xwA, 0, 0);
            ER_ROWS(stA, xwA, 0, 1); ER_DO(stB, xwB, 1, 0);
            ER_COLS(1); ER_ROWS(stB, xwB, 1, 1); ER_DO(stA, xwA, 0, 1);
            ER_DO(stB, xwB, 1, 1);
#undef ER_ROWS
#undef ER_COLS
#undef ER_DO
        } else {
#pragma unroll
        for (int ai = 0; ai < 2; ++ai)
#pragma unroll
        for (int bj = 0; bj < 2; ++bj) {
            f32x2 st[4]; f32x4 xa[4], xb[4]; u32x4 xw[4]; f32x4 gmv[2], lgv[2], lbv[2];
#pragma unroll
            for (int n = 0; n < 2; ++n) { gmv[n] = (*(const f32x4*)(gv + col0 + bj * HALF + n * 4) + 1.0f) * wgt;
                if (!XF32) { lgv[n] = *(const f32x4*)(lng + col0 + bj * HALF + n * 4) * alpha; lbv[n] = *(const f32x4*)(lnb + col0 + bj * HALF + n * 4) * alpha; } }
#pragma unroll
            for (int m = 0; m < 4; ++m) { const int row = row0 + ai * HALF + m * 16; const size_t ro = (size_t)row * LDC + col0;
                st[m] = (f32x2){0.f, 1.f}; if (!XF32) st[m] = *(const f32x2*)(stats + 2 * (size_t)row);
                if (XF32) { xa[m] = *(const f32x4*)(xf32 + ro + bj * HALF); xb[m] = *(const f32x4*)(xf32 + ro + bj * HALF + 4); }
                else xw[m] = *(const u32x4*)(out + ro + bj * HALF); }
#pragma unroll
            for (int m = 0; m < 4; ++m) { const int row = row0 + ai * HALF + m * 16; const size_t ro = (size_t)row * LDC + col0; f32x4 x0, x1;
                if (XF32) { x0 = xa[m] * alpha; x1 = xb[m] * alpha; }
                else { const u32x4 w = xw[m];
                    x0 = (f32x4){h_lo(w.x), h_hi(w.x), h_lo(w.y), h_hi(w.y)}; x1 = (f32x4){h_lo(w.z), h_hi(w.z), h_lo(w.w), h_hi(w.w)};
                    x0 = (x0 - st[m].x) * st[m].y * lgv[0] + lbv[0]; x1 = (x1 - st[m].x) * st[m].y * lgv[1] + lbv[1]; }
                const f32x4 v0 = x0 + gmv[0] * acc[ai][bj][m][0], v1 = x1 + gmv[1] * acc[ai][bj][m][1];
                u32x4 o; o.x = pk_h2(v0[0], v0[1]); o.y = pk_h2(v0[2], v0[3]); o.z = pk_h2(v1[0], v1[1]); o.w = pk_h2(v1[2], v1[3]);
                *(u32x4*)(out + ro + bj * HALF) = o; }
        }
        }
    }
};

struct EpiMerge {
    static constexpr bool PERM = true, AFTER_DRAIN = false; static constexpr int MID_T = 16;
    const bf16_t* sga; const bf16_t* sgb; bf16_t* O; int ldc;
    __device__ __forceinline__ void mid(f32x4 (&acc)[2][2][4][2], const Unit& u, int wr, int wc, int fr, int fq) const {
        int z_; asm volatile("v_mov_b32 %0, 0" : "=v"(z_));
        const int row0 = u.pm * BM + wr * 64 + fr + z_, col0 = u.pn * BM + wc * 32 + 8 * fq;
        const unsigned ob = (unsigned)(row0 * ldc + col0) * 2u;
        u32x4 gaA[4], gbA[4], gaB[4], gbB[4];
#define EM_LD(GA, GB, ai_, bj_) do { _Pragma("unroll") for (int m = 0; m < 4; ++m) { const unsigned o_ = ob + (unsigned)((((ai_) * HALF + m * 16) * ldc + (bj_) * HALF) * 2); \
            GA[m] = *(const u32x4*)((const char*)sga + o_); GB[m] = *(const u32x4*)((const char*)sgb + o_); } } while (0)
#define EM_DO(GA, GB, ai_, bj_) do { _Pragma("unroll") for (int m = 0; m < 4; ++m) { const u32x4 a = GA[m], b = GB[m]; \
            f32x4 r0 = {bf_lo(a.x) * __builtin_amdgcn_rcpf(fmaxf(bf_lo(b.x), 1e-30f)), bf_hi(a.x) * __builtin_amdgcn_rcpf(fmaxf(bf_hi(b.x), 1e-30f)), bf_lo(a.y) * __builtin_amdgcn_rcpf(fmaxf(bf_lo(b.y), 1e-30f)), bf_hi(a.y) * __builtin_amdgcn_rcpf(fmaxf(bf_hi(b.y), 1e-30f))}; \
            f32x4 r1 = {bf_lo(a.z) * __builtin_amdgcn_rcpf(fmaxf(bf_lo(b.z), 1e-30f)), bf_hi(a.z) * __builtin_amdgcn_rcpf(fmaxf(bf_hi(b.z), 1e-30f)), bf_lo(a.w) * __builtin_amdgcn_rcpf(fmaxf(bf_lo(b.w), 1e-30f)), bf_hi(a.w) * __builtin_amdgcn_rcpf(fmaxf(bf_hi(b.w), 1e-30f))}; \
            acc[ai_][bj_][m][0] = acc[ai_][bj_][m][0] * r0; acc[ai_][bj_][m][1] = acc[ai_][bj_][m][1] * r1; } } while (0)
        EM_LD(gaA, gbA, 0, 0);
        EM_LD(gaB, gbB, 0, 1); EM_DO(gaA, gbA, 0, 0);
        EM_LD(gaA, gbA, 1, 0); EM_DO(gaB, gbB, 0, 1);
        EM_LD(gaB, gbB, 1, 1); EM_DO(gaA, gbA, 1, 0);
        EM_DO(gaB, gbB, 1, 1);
#undef EM_LD
#undef EM_DO
        asm volatile("s_waitcnt vmcnt(0)" ::: "memory");
    }
    __device__ __forceinline__ void operator()(const f32x4 (&acc)[2][2][4][2], const Unit& u, int wr, int wc, int fr, int fq) const {
        int z_; asm volatile("v_mov_b32 %0, 0" : "=v"(z_));
        const int row0 = u.pm * BM + wr * 64 + (fr + z_), col0 = u.pn * BM + wc * 32 + 8 * (fq + z_);
        const unsigned ob = (unsigned)(row0 * ldc + col0) * 2u;
        u32x4 gbA[4], gbB[4];
#define EF_LD(GB, ai_, bj_) do { _Pragma("unroll") for (int m = 0; m < 4; ++m) GB[m] = *(const u32x4*)((const char*)sgb + (ob + (unsigned)((((ai_) * HALF + m * 16) * ldc + (bj_) * HALF) * 2))); } while (0)
#define EF_DO(GB, ai_, bj_) do { _Pragma("unroll") for (int m = 0; m < 4; ++m) { const u32x4 b = GB[m]; f32x4 v0 = acc[ai_][bj_][m][0], v1 = acc[ai_][bj_][m][1]; \
            v0[0] *= bf_lo(b.x); v0[1] *= bf_hi(b.x); v0[2] *= bf_lo(b.y); v0[3] *= bf_hi(b.y); v1[0] *= bf_lo(b.z); v1[1] *= bf_hi(b.z); v1[2] *= bf_lo(b.w); v1[3] *= bf_hi(b.w); \
            u32x4 w; w.x = cvt_pk_bf16(v0[0], v0[1]); w.y = cvt_pk_bf16(v0[2], v0[3]); w.z = cvt_pk_bf16(v1[0], v1[1]); w.w = cvt_pk_bf16(v1[2], v1[3]); \
            *(u32x4*)((char*)O + (ob + (unsigned)((((ai_) * HALF + m * 16) * ldc + (bj_) * HALF) * 2))) = w; } } while (0)
        EF_LD(gbA, 0, 0);
        EF_LD(gbB, 0, 1); EF_DO(gbA, 0, 0);
        EF_LD(gbA, 1, 0); EF_DO(gbB, 0, 1);
        EF_LD(gbB, 1, 1); EF_DO(gbA, 1, 0);
        EF_DO(gbB, 1, 1);
#undef EF_LD
#undef EF_DO
    }
};

struct RevOrder : StaticOrder {
    __device__ __forceinline__ bool next(int i, Unit& u) const { const bool r = StaticOrder::next(i, u); u.pn = nN - 1 - u.pn; return r; }
};
template <class Epi, class Sched, bool ALIGN_EPI = false, bool SP2 = false>
__device__ __forceinline__ void gemm_phase(PG8_LAS unsigned char* lds, const Gemm g, const Sched& S, const Epi& E) {
    const int tid = threadIdx.x, wid = __builtin_amdgcn_readfirstlane(tid >> 6), lane = tid & 63, wr = wid >> 2, wc = wid & 3, fr = lane & 15, fq = lane >> 4;
    const int K = g.K, nt = K / BK;
    unsigned voffA[2], voffB[2];
#pragma unroll
    for (int i = 0; i < 2; ++i) { int R, C; stage_rc(tid * 16 + i * 8192, R, C); const int Rb = Epi::PERM ? ((R & ~31) + perm32(R & 31)) : R;
        voffA[i] = (unsigned)(R * K + C) * 2u; voffB[i] = (unsigned)(Rb * K + C) * 2u; }
    const size_t kstep = (size_t)(BK * 2);
    const size_t hstep = (size_t)HALF * K * 2;
    const size_t tstep = 2 * hstep;
    const unsigned ldsw = (unsigned)wid * 1024u;
    const int aoff = lds_byte(wr * 64 + fr, fq * 8), boff = lds_byte(wc * 32 + fr, fq * 8);
#define PG8_SA(b, h) (((b) * 2 + (h)) * HTB)
#define PG8_SB(b, h) ((4 + (b) * 2 + (h)) * HTB)
#define PG8_STAGE(bufoff, gbase, voff) do { _Pragma("unroll") for (int _i = 0; _i < 2; ++_i) \
        __builtin_amdgcn_global_load_lds((const unsigned*)((const char*)(gbase) + (voff)[_i]), (PG8_LAS unsigned*)(lds + (bufoff) + ldsw + _i * 8192), 16, 0, 0); } while (0)
#define PG8_LDA(dst, b, h) do { _Pragma("unroll") for (int m = 0; m < 4; ++m) _Pragma("unroll") for (int k = 0; k < 2; ++k) dst[m][k] = *(const PG8_LAS bf16x8*)(lds + PG8_SA(b, h) + aoff + m * 2048 + k * 1024); } while (0)
#define PG8_LDB(dst, b, h) do { _Pragma("unroll") for (int n = 0; n < 2; ++n) _Pragma("unroll") for (int k = 0; k < 2; ++k) dst[n][k] = *(const PG8_LAS bf16x8*)(lds + PG8_SB(b, h) + boff + n * 2048 + k * 1024); } while (0)
#define PG8_MMA(ai, bj, At, Bt) do { __builtin_amdgcn_s_setprio(1); _Pragma("unroll") for (int m = 0; m < 4; ++m) _Pragma("unroll") for (int n = 0; n < 2; ++n) _Pragma("unroll") for (int k = 0; k < 2; ++k) \
        acc[ai][bj][m][n] = __builtin_amdgcn_mfma_f32_16x16x32_bf16(Bt[n][k], At[m][k], acc[ai][bj][m][n], 0, 0, 0); __builtin_amdgcn_s_setprio(0); } while (0)
#define PG8_WAIT_V(n) asm volatile("s_waitcnt vmcnt(" #n ")" ::: "memory")
#define PG8_WAIT_L(n) asm volatile("s_waitcnt lgkmcnt(" #n ")" ::: "memory")
#define PG8_BAR __builtin_amdgcn_s_barrier()
#define PG8_SCHED __builtin_amdgcn_sched_barrier(0)
    Unit cur, nxt; int ui = 0;
    if (!S.next(0, cur)) return;
    f32x4 acc[2][2][4][2];
#pragma unroll
    for (int a = 0; a < 2; ++a)
#pragma unroll
        for (int b = 0; b < 2; ++b)
#pragma unroll
            for (int m = 0; m < 4; ++m)
#pragma unroll
                for (int n = 0; n < 2; ++n) acc[a][b][m][n] = (f32x4){0.f, 0.f, 0.f, 0.f};
    bf16x8 At[4][2], B0[2][2], B1[2][2];
    const char* cA = (const char*)g.A + (size_t)cur.pm * tstep; const char* cB = (const char*)g.Bt + (size_t)cur.pn * tstep;
    S.a_ready(cur);
    if constexpr (SP2) {
        PG8_STAGE(PG8_SB(0, 0), cB, voffB); PG8_STAGE(PG8_SB(0, 1), cB + hstep, voffB); PG8_STAGE(PG8_SA(0, 0), cA, voffA); PG8_STAGE(PG8_SA(0, 1), cA + hstep, voffA);
        if (wr == 1) PG8_BAR;
        PG8_WAIT_V(2); PG8_BAR;
        PG8_STAGE(PG8_SB(1, 0), cB + kstep, voffB); PG8_STAGE(PG8_SA(1, 0), cA + kstep, voffA); PG8_STAGE(PG8_SB(1, 1), cB + hstep + kstep, voffB);
        PG8_WAIT_V(6); PG8_BAR;
    } else {
        PG8_STAGE(PG8_SB(0, 0), cB, voffB); PG8_STAGE(PG8_SA(0, 0), cA, voffA); PG8_STAGE(PG8_SB(0, 1), cB + hstep, voffB); PG8_STAGE(PG8_SA(0, 1), cA + hstep, voffA);
        if (wr == 1) PG8_BAR;
        PG8_WAIT_V(4); PG8_BAR;
        PG8_STAGE(PG8_SB(1, 0), cB + kstep, voffB); PG8_STAGE(PG8_SA(1, 0), cA + kstep, voffA); PG8_STAGE(PG8_SB(1, 1), cB + hstep + kstep, voffB);
        PG8_WAIT_V(6); PG8_BAR;
    }
    for (;;) {
        const bool has_next = S.next(ui + 1, nxt);
        const char* nA = has_next ? (const char*)g.A + (size_t)nxt.pm * tstep : cA; const char* nB = has_next ? (const char*)g.Bt + (size_t)nxt.pn * tstep : cB;
        constexpr int NSEG = Epi::MID_T >= 0 ? 2 : 1;
#pragma unroll 1
        for (int seg = 0; seg < NSEG; ++seg) {
        if constexpr (Epi::MID_T >= 0) { if (seg == 1) E.mid(acc, cur, wr, wc, fr, fq); }
        const int t_lo = (NSEG == 2 && seg == 1) ? Epi::MID_T : 0, t_hi = (NSEG == 2 && seg == 0) ? Epi::MID_T : nt;
        for (int t = t_lo; t < t_hi; t += 2) {
            const bool last = (t == nt - 2);
            const char* a1 = cA + (size_t)(t + 1) * kstep;
            const char* a2 = last ? nA : cA + (size_t)(t + 2) * kstep; const char* b2 = last ? nB : cB + (size_t)(t + 2) * kstep;
            const char* a3 = a2 + kstep; const char* b3 = b2 + kstep;
            if (last && has_next) S.a_ready(nxt);
            if constexpr (SP2) {
            PG8_LDB(B0, 0, 0); PG8_LDB(B1, 0, 1); PG8_SCHED; PG8_LDA(At, 0, 0); PG8_STAGE(PG8_SA(1, 1), a1 + hstep, voffA);
            PG8_WAIT_V(8); PG8_WAIT_L(0); PG8_BAR; PG8_MMA(0, 0, At, B0); PG8_MMA(0, 1, At, B1); PG8_BAR; PG8_SCHED;
            PG8_LDA(At, 0, 1); PG8_STAGE(PG8_SB(0, 0), b2, voffB); PG8_STAGE(PG8_SB(0, 1), b2 + hstep, voffB); PG8_STAGE(PG8_SA(0, 0), a2, voffA);
            PG8_WAIT_V(8); PG8_WAIT_L(0); PG8_BAR; PG8_MMA(1, 0, At, B0); PG8_MMA(1, 1, At, B1); PG8_BAR; PG8_SCHED;
            PG8_LDB(B0, 1, 0); PG8_LDB(B1, 1, 1); PG8_SCHED; PG8_LDA(At, 1, 0); PG8_STAGE(PG8_SA(0, 1), a2 + hstep, voffA);
            PG8_WAIT_V(8); PG8_WAIT_L(0); PG8_BAR; PG8_MMA(0, 0, At, B0); PG8_MMA(0, 1, At, B1); PG8_BAR; PG8_SCHED;
            PG8_LDA(At, 1, 1); PG8_STAGE(PG8_SB(1, 0), b3, voffB); PG8_STAGE(PG8_SB(1, 1), b3 + hstep, voffB); PG8_STAGE(PG8_SA(1, 0), a3, voffA);
            PG8_WAIT_V(8); PG8_WAIT_L(0); PG8_BAR; PG8_MMA(1, 0, At, B0); PG8_MMA(1, 1, At, B1); PG8_BAR; PG8_SCHED;
            } else {
            PG8_LDB(B0, 0, 0); PG8_SCHED; PG8_LDA(At, 0, 0); PG8_STAGE(PG8_SA(1, 1), a1 + hstep, voffA);
            PG8_WAIT_L(8); PG8_BAR; PG8_WAIT_L(0); PG8_MMA(0, 0, At, B0); PG8_BAR; PG8_SCHED;
            PG8_LDB(B1, 0, 1); PG8_STAGE(PG8_SB(0, 0), b2, voffB);
            PG8_BAR; PG8_WAIT_L(0); PG8_MMA(0, 1, At, B1); PG8_BAR;
            PG8_LDA(At, 0, 1); PG8_STAGE(PG8_SA(0, 0), a2, voffA);
            PG8_BAR; PG8_WAIT_L(0); PG8_MMA(1, 0, At, B0); PG8_BAR; PG8_SCHED;
            PG8_STAGE(PG8_SB(0, 1), b2 + hstep, voffB);
            PG8_WAIT_V(6); PG8_BAR; PG8_MMA(1, 1, At, B1); PG8_BAR;
            PG8_LDB(B0, 1, 0); PG8_SCHED; PG8_LDA(At, 1, 0); PG8_STAGE(PG8_SA(0, 1), a2 + hstep, voffA);
            PG8_WAIT_L(8); PG8_BAR; PG8_WAIT_L(0); PG8_MMA(0, 0, At, B0); PG8_BAR; PG8_SCHED;
            PG8_LDB(B1, 1, 1); PG8_STAGE(PG8_SB(1, 0), b3, voffB);
            PG8_BAR; PG8_WAIT_L(0); PG8_MMA(0, 1, At, B1); PG8_BAR;
            PG8_LDA(At, 1, 1); PG8_STAGE(PG8_SA(1, 0), a3, voffA);
            PG8_BAR; PG8_WAIT_L(0); PG8_MMA(1, 0, At, B0); PG8_BAR; PG8_SCHED;
            PG8_STAGE(PG8_SB(1, 1), b3 + hstep, voffB);
            PG8_WAIT_V(6); PG8_BAR; PG8_MMA(1, 1, At, B1); PG8_BAR;
            }
        }
        }
        if constexpr (ALIGN_EPI) { if (wr == 0) PG8_BAR; }
        if constexpr (!Epi::AFTER_DRAIN) { E(acc, cur, wr, wc, fr, fq);
#if defined(PG8_EPI_REP2)
            asm volatile("" ::: "memory"); E(acc, cur, wr, wc, fr, fq);
#endif
            S.done(cur); }
        if (!has_next) break;
#pragma unroll
        for (int a = 0; a < 2; ++a)
#pragma unroll
            for (int b = 0; b < 2; ++b)
#pragma unroll
                for (int m = 0; m < 4; ++m)
#pragma unroll
                    for (int n = 0; n < 2; ++n) acc[a][b][m][n] = (f32x4){0.f, 0.f, 0.f, 0.f};
        cur = nxt; cA = nA; cB = nB; ++ui;
        if constexpr (ALIGN_EPI) { if (wr == 1) PG8_BAR; }
    }
    PG8_WAIT_V(0);
    if constexpr (!ALIGN_EPI) { if (wr == 0) PG8_BAR; }
    PG8_BAR;
    if constexpr (Epi::AFTER_DRAIN) { E.fused(acc, cur, wr, wc, fr, fq, lds, wid, lane); S.done(cur); }
#undef PG8_SA
#undef PG8_SB
#undef PG8_STAGE
#undef PG8_LDA
#undef PG8_LDB
#undef PG8_MMA
#undef PG8_WAIT_V
#undef PG8_WAIT_L
#undef PG8_BAR
#undef PG8_SCHED
}
}
constexpr int BATCH = 4, SEQ = 4096, DM = 2048, MTOK = BATCH * SEQ, FF = 5632, NIN = 11264, HW = 1024, NH = 8, HD = 128, DEPTH = 2, NSUB = 3;
constexpr int NMOD = NSUB * 3 * DM;
constexpr float DN_ALPHA = 1.4142135623730951f;
constexpr float LN_EPS = 1e-5f, RMS_EPS = 1e-6f, F_MIN = 1e-30f;
constexpr float ATT_C2 = 0.08838834764831845f * 1.4426950408889634f;
constexpr int MB_BLOCK = 256, MB_NB = SEQ / MB_BLOCK, MB_TOPK = 3;
constexpr int NWAVES = 8;

constexpr size_t MiB = 1u << 20;
constexpr size_t WS_CTL = 0, CTL_ZERO_BYTES = 1 * MiB;
constexpr size_t WS_MOD = 1 * MiB;
constexpr size_t WS_MODP = 2 * MiB;
constexpr size_t WS_KMEAN = 12 * MiB;
constexpr size_t WS_SEL = 12 * MiB + 512 * 1024;
constexpr size_t WS_GTOT = 13 * MiB;
constexpr size_t WS_WTS = 16 * MiB, WL_STRIDE = 192 * MiB;
constexpr size_t WO_GU = 0, WO_D = 88 * MiB, WO_IN = 132 * MiB, WO_A = 176 * MiB, WO_B = 180 * MiB, WO_O = 184 * MiB;
constexpr size_t WS_V = 400 * MiB;
constexpr size_t WS_STATS = 14 * MiB;
constexpr size_t WS_H = 464 * MiB;
constexpr size_t WS_R = 528 * MiB;
constexpr size_t R_ACT = 0;
constexpr size_t R_Q = 176 * MiB, R_VV = 208 * MiB, R_SG = 240 * MiB, R_MQ = 272 * MiB, R_MK = 304 * MiB, R_MV = 336 * MiB, R_GA = 368 * MiB, R_GB = 432 * MiB, R_Z = 496 * MiB  ;
constexpr size_t R_SLOC = 560 * MiB;
constexpr size_t R_MVT = 448 * MiB;
constexpr size_t R_T = 384 * MiB;
constexpr size_t R_HO = 512 * MiB;
constexpr size_t WS_END = WS_R + 624 * MiB;
constexpr size_t DO_B = 32 * MiB, DO_Z = 0, DO_SL = 8 * MiB, DO_MVT = 12 * MiB;
constexpr size_t Z_BADD = DO_B - 8 * MiB, SL_BADD = DO_B - 4 * MiB, MVT_BADD = DO_B - 8 * MiB;

constexpr int CW_BAR = 4096;

constexpr int LDS_BYTES = 147456, MISC_OFF = LDS_BYTES - 512;

#define GAS __attribute__((address_space(1)))
#define LAS __attribute__((address_space(3)))
typedef unsigned short bf16;
typedef unsigned v4u __attribute__((ext_vector_type(4)));
typedef unsigned v2u __attribute__((ext_vector_type(2)));
typedef float f32x4 __attribute__((ext_vector_type(4)));
typedef float f32x2 __attribute__((ext_vector_type(2)));
#define LDS_WAIT() asm volatile("s_waitcnt lgkmcnt(0)" ::: "memory")
#define VM_WAIT() asm volatile("s_waitcnt vmcnt(0)" ::: "memory")
__device__ __forceinline__ unsigned f2bf(float f) { unsigned u = __builtin_bit_cast(unsigned, f); return (u + 0x7fffu + ((u >> 16) & 1u)) >> 16; }
__device__ __forceinline__ unsigned pk2(float lo, float hi) { return f2bf(lo) | (f2bf(hi) << 16); }
__device__ __forceinline__ float bf2f(bf16 v) { return __uint_as_float((unsigned)v << 16); }
__device__ __forceinline__ float wave_sum(float v) {
#pragma unroll
    for (int o = 1; o < 64; o <<= 1) v += __shfl_xor(v, o);
    return v;
}
__device__ __forceinline__ float wave_max(float v) {
#pragma unroll
    for (int o = 1; o < 64; o <<= 1) v = fmaxf(v, __shfl_xor(v, o));
    return v;
}
using pg8::silu_f; using pg8::sigm_f;
#define XB_TMO      128
#define XB_XCNT(j)  (256  + 64 * (j))
#define XB_XSUB(j)  (1280 + 64 * (j))
#define XB_XGEN(j)  (2304 + 64 * (j))
#define XB_TOP      3328
#define XB_TOPGEN   3392
#define XCD_BAR_WORDS 3456
#define XB_SPIN_CAP (1u << 18)

__device__ __forceinline__ unsigned xb_ld(unsigned* p)              { return __hip_atomic_load(p, __ATOMIC_RELAXED, __HIP_MEMORY_SCOPE_AGENT); }
__device__ __forceinline__ unsigned xb_add(unsigned* p, unsigned v) { return __hip_atomic_fetch_add(p, v, __ATOMIC_RELAXED, __HIP_MEMORY_SCOPE_AGENT); }
__device__ __forceinline__ unsigned xb_xcc_id() { return (unsigned)__builtin_amdgcn_s_getreg((3 << 11) | 20) & 0xFu; }
#define XB_SPIN(cond, bar) do { unsigned _sp = 0; while (cond) { __builtin_amdgcn_s_sleep(1); \
    if ((++_sp & 255u) == 0u) { if (xb_ld(&(bar)[XB_TMO])) break; if (_sp > XB_SPIN_CAP) { atomicAdd(&(bar)[XB_TMO], 1u); break; } } } } while (0)

struct XcdBarrier {
    unsigned* bar; unsigned x;
    unsigned gsize;
    volatile LAS unsigned* st;
};

__device__ __forceinline__ XcdBarrier xcd_barrier_post(unsigned* bar, volatile LAS unsigned* st, unsigned gsize) {
    XcdBarrier b; b.bar = bar; b.x = xb_xcc_id(); b.st = st; b.gsize = gsize;
    if (threadIdx.x == 0) (void)xb_add(&bar[XB_XCNT(b.x)], 1u);
    return b;
}
__device__ __forceinline__ void xcd_barrier_complete(unsigned* bar, unsigned x, unsigned& nloc, unsigned& nx, unsigned G) {
    unsigned sum, cnt, mine, sp = 0u;
    for (;;) {
        sum = 0u; cnt = 0u; mine = 0u;
#pragma unroll
        for (unsigned j = 0; j < 16; ++j) { const unsigned c = xb_ld(&bar[XB_XCNT(j)]); sum += c; cnt += (c > 0u) ? 1u : 0u; mine = (j == x) ? c : mine; }
        if (sum == G) break;
        __builtin_amdgcn_s_sleep(1);
        if ((++sp & 255u) == 0u) { if (xb_ld(&bar[XB_TMO])) break; if (sp > XB_SPIN_CAP) { atomicAdd(&bar[XB_TMO], 1u); break; } }
    }
    nloc = mine > 0u ? mine : 1u; nx = cnt > 0u ? cnt : 1u;
}

__device__ __forceinline__ void xcd_barrier(const XcdBarrier& b) {
    asm volatile("s_waitcnt vmcnt(0)" ::: "memory");
    __syncthreads();
    if (threadIdx.x == 0) {
        unsigned* bar = b.bar;
        __builtin_amdgcn_s_waitcnt(0);
        unsigned nloc = b.st[0], nx = b.st[1];
        if (nloc == 0u) { xcd_barrier_complete(bar, b.x, nloc, nx, b.gsize); b.st[0] = nloc; b.st[1] = nx; }
        const unsigned old = xb_add(&bar[XB_XSUB(b.x)], 1u);
        const unsigned gen = old / nloc;
        if (old + 1u == (gen + 1u) * nloc) {
            __builtin_amdgcn_fence(__ATOMIC_RELEASE, "agent");
            asm volatile("s_waitcnt vmcnt(0)" ::: "memory");
            const unsigned og = xb_add(&bar[XB_TOP], 1u);
            const unsigned tg = og / nx;
            if (og + 1u == (tg + 1u) * nx) xb_add(&bar[XB_TOPGEN], 1u);
            else XB_SPIN(xb_ld(&bar[XB_TOPGEN]) == tg, bar);
            __builtin_amdgcn_fence(__ATOMIC_ACQUIRE, "agent");
            xb_add(&bar[XB_XGEN(b.x)], 1u);
            asm volatile("s_waitcnt vmcnt(0)" ::: "memory");
        } else {
            XB_SPIN(xb_ld(&bar[XB_XGEN(b.x)]) == gen, bar);
            __builtin_amdgcn_fence(__ATOMIC_ACQUIRE, "agent");
            asm volatile("s_waitcnt vmcnt(0)" ::: "memory");
        }
    }
    __syncthreads();
}
__device__ __forceinline__ float lower_bound_of(const float* lbl, int l, int col) {
    float m = lbl[col];
#pragma unroll
    for (int j = 1; j < DEPTH; ++j) m = fmaxf(m, lbl[j * HW + col]);
    float den = 0.f, num = 0.f;
#pragma unroll
    for (int j = 0; j < DEPTH; ++j) { const float e = __expf(lbl[j * HW + col] - m); den += e; if (j >= 1 && j <= l) num += e; }
    return num / den;
}

__device__ __forceinline__ void transpose_item64(const float* W, int N, bf16* WT, int ldk, int k0, int n0, int orow0, LAS float* scr, int lane, int kdst = -1) {
    if (kdst < 0) kdst = k0;
    f32x4 v[16];
#pragma unroll
    for (int i = 0; i < 16; ++i) v[i] = __builtin_nontemporal_load((const f32x4*)(W + (size_t)(k0 + 4 * i + (lane >> 4)) * N + n0 + (lane & 15) * 4));
#pragma unroll
    for (int i = 0; i < 16; ++i) { LAS float* s = scr + (4 * i + (lane >> 4)) * 65 + (lane & 15) * 4; s[0] = v[i].x; s[1] = v[i].y; s[2] = v[i].z; s[3] = v[i].w; }
    LDS_WAIT(); asm volatile("" ::: "memory");
    const int c = lane & 7;
#pragma unroll
    for (int j = 0; j < 8; ++j) { const int n = (lane >> 3) + 8 * j; const LAS float* s = scr + (8 * c) * 65 + n;
        v4u o; o.x = pk2(s[0 * 65], s[1 * 65]); o.y = pk2(s[2 * 65], s[3 * 65]); o.z = pk2(s[4 * 65], s[5 * 65]); o.w = pk2(s[6 * 65], s[7 * 65]);
        *(v4u*)(WT + (size_t)(orow0 + n) * ldk + kdst + 8 * c) = o; }
    LDS_WAIT(); asm volatile("" ::: "memory");
}
constexpr int CV_GU = 4 * 2816, CV_D = 2 * 2816, CV_IN = 5632, CV_A = 512, CV_B = 512, CV_O = 1024, CV_LAYER = CV_GU + CV_D + CV_IN + CV_A + CV_B + CV_O;
__device__ __forceinline__ void convert_item(int it, const float* wg, const float* wu, const float* wd, const float* win, const float* wa, const float* wb, const float* wo, unsigned char* wts, LAS float* scr, int lane) {
    const int l = it / CV_LAYER; int r = it % CV_LAYER; unsigned char* wl = wts + (size_t)l * WL_STRIDE;
    if (r < CV_GU) { const int mat = r / 2816, rem = r % 2816, f = mat >> 1, isup = mat & 1, kb = rem / 88, nb = rem % 88, n0 = nb * 64;
        const float* src = (isup ? wu : wg) + (size_t)(l * 2 + f) * DM * FF;
        transpose_item64(src, FF, (bf16*)(wl + WO_GU) + (size_t)f * NIN * DM, DM, kb * 64, n0, 256 * (n0 >> 7) + (n0 & 127) + 128 * isup, scr, lane); return; }
    r -= CV_GU;
    if (r < CV_D) { const int f = r / 2816, rem = r % 2816, kb = rem / 32, nb = rem % 32;
        transpose_item64(wd + (size_t)(l * 2 + f) * FF * DM, DM, (bf16*)(wl + WO_D) + (size_t)f * DM * FF, FF, kb * 64, nb * 64, nb * 64, scr, lane); return; }
    r -= CV_D;
    if (r < CV_IN) { const int kb = r / 176, nb = r % 176;
        transpose_item64(win + (size_t)l * DM * NIN, NIN, (bf16*)(wl + WO_IN), DM, kb * 64, nb * 64, nb * 64, scr, lane); return; }
    r -= CV_IN;
    if (r < CV_A) { const int kb = r / 32, nb = r % 32;
        transpose_item64(wa + (size_t)l * HW * DM, DM, (bf16*)(wl + WO_A), 2 * HW, kb * 64, nb * 64, nb * 64, scr, lane); return; }
    r -= CV_A;
    if (r < CV_B) { const int kb = r / 32, nb = r % 32;
        transpose_item64(wb + (size_t)l * HW * DM, DM, (bf16*)(wl + WO_A), 2 * HW, kb * 64, nb * 64, nb * 64, scr, lane, HW + kb * 64); return; }
    r -= CV_B;
    { const int kb = r / 32, nb = r % 32;
        transpose_item64(wo + (size_t)l * DM * DM, DM, (bf16*)(wl + WO_O), DM, kb * 64, nb * 64, nb * 64, scr, lane); }
}
__device__ __forceinline__ void adaln_item(int it, const float* ada_w, float* modp, const LAS float* condT, int lane) {
    const int strip = it % 144, ks = it / 144, l = strip / 72, s = strip % 72;
    const float* wp = ada_w + ((size_t)l * DM + ks * 128) * NMOD + s * 256 + lane * 4;
    f32x4 a0 = {0.f, 0.f, 0.f, 0.f}, a1 = a0, a2 = a0, a3 = a0;
#pragma unroll 16
    for (int k = 0; k < 128; ++k) { const f32x4 w = __builtin_nontemporal_load((const f32x4*)(wp + (size_t)k * NMOD)); const f32x4 cd = *(const LAS f32x4*)(condT + (ks * 128 + k) * 4);
        a0 += w * cd.x; a1 += w * cd.y; a2 += w * cd.z; a3 += w * cd.w; }
    float* o = modp + (size_t)(ks * 4) * (DEPTH * NMOD) + l * NMOD + s * 256 + lane * 4;
    *(f32x4*)(o) = a0; *(f32x4*)(o + DEPTH * NMOD) = a1; *(f32x4*)(o + 2 * DEPTH * NMOD) = a2; *(f32x4*)(o + 3 * DEPTH * NMOD) = a3;
}

__device__ __forceinline__ void modulate_row(const float* xrow, bf16* hrow, const float* shift, const float* scale, int lane) {
#pragma unroll
    for (int j = 0; j < 8; ++j) { const int c = (lane + 64 * j) * 4; const f32x4 x = *(const f32x4*)(xrow + c), sc = *(const f32x4*)(scale + c), sh = *(const f32x4*)(shift + c);
        const f32x4 h = x * (sc + 1.0f) + sh; v2u o; o.x = pk2(h.x, h.y); o.y = pk2(h.z, h.w); *(v2u*)(hrow + c) = o; }
}
using pg8::pk_h2; using pg8::h_lo; using pg8::h_hi;
struct LnRowRegs { float v[4][8]; };
__device__ __forceinline__ void ln_row_load(LnRowRegs& R, const unsigned short* vrow, int lane) {
#pragma unroll
    for (int j = 0; j < 4; ++j) { const v4u w = *(const v4u*)(vrow + (lane + 64 * j) * 8);
        R.v[j][0] = h_lo(w.x); R.v[j][1] = h_hi(w.x); R.v[j][2] = h_lo(w.y); R.v[j][3] = h_hi(w.y); R.v[j][4] = h_lo(w.z); R.v[j][5] = h_hi(w.z); R.v[j][6] = h_lo(w.w); R.v[j][7] = h_hi(w.w); }
}
__device__ __forceinline__ void ln_row_finish(LnRowRegs& R, float* strow  , float* xf, bf16* hrow, const float* g, const float* bta, const float* shift, const float* scale, int lane) {
    float s = 0.f;
#pragma unroll
    for (int j = 0; j < 4; ++j)
#pragma unroll
        for (int i = 0; i < 8; ++i) s += R.v[j][i];
    const float mean = wave_sum(s) * (1.f / DM); float s2 = 0.f;
#pragma unroll
    for (int j = 0; j < 4; ++j)
#pragma unroll
        for (int i = 0; i < 8; ++i) { R.v[j][i] -= mean; s2 += R.v[j][i] * R.v[j][i]; }
    const float rstd = 1.f / sqrtf(wave_sum(s2) * (1.f / DM) + LN_EPS);
    if (strow && lane == 0) { strow[0] = mean; strow[1] = rstd; }
#pragma unroll
    for (int j = 0; j < 4; ++j) { const int c = (lane + 64 * j) * 8; float x[8];
        const f32x4 g0 = *(const f32x4*)(g + c), g1 = *(const f32x4*)(g + c + 4), b0 = *(const f32x4*)(bta + c), b1 = *(const f32x4*)(bta + c + 4);
#pragma unroll
        for (int i = 0; i < 4; ++i) { x[i] = R.v[j][i] * rstd * g0[i] + b0[i]; x[4 + i] = R.v[j][4 + i] * rstd * g1[i] + b1[i]; }
        if (xf) { *(f32x4*)(xf + c) = (f32x4){x[0], x[1], x[2], x[3]}; *(f32x4*)(xf + c + 4) = (f32x4){x[4], x[5], x[6], x[7]}; }
        if (hrow) { const f32x4 s0 = *(const f32x4*)(scale + c), s1 = *(const f32x4*)(scale + c + 4), h0 = *(const f32x4*)(shift + c), h1 = *(const f32x4*)(shift + c + 4); float h[8];
#pragma unroll
            for (int i = 0; i < 4; ++i) { h[i] = x[i] * (s0[i] + 1.0f) + h0[i]; h[4 + i] = x[4 + i] * (s1[i] + 1.0f) + h1[i]; }
            v4u o; o.x = pk2(h[0], h[1]); o.y = pk2(h[2], h[3]); o.z = pk2(h[4], h[5]); o.w = pk2(h[6], h[7]); *(v4u*)(hrow + c) = o; } }
}

__device__ __forceinline__ void ln_row_finish_pc(LnRowRegs& R, float* strow  , float* xf, bf16* hrow, const f32x4 (&Gp)[4][2], const f32x4 (&Bp)[4][2], int lane) {
    float s = 0.f;
#pragma unroll
    for (int j = 0; j < 4; ++j)
#pragma unroll
        for (int i = 0; i < 8; ++i) s += R.v[j][i];
    const float mean = wave_sum(s) * (1.f / DM); float s2 = 0.f;
#pragma unroll
    for (int j = 0; j < 4; ++j)
#pragma unroll
        for (int i = 0; i < 8; ++i) { R.v[j][i] -= mean; s2 += R.v[j][i] * R.v[j][i]; }
    const float rstd = 1.f / sqrtf(wave_sum(s2) * (1.f / DM) + LN_EPS);
    if (strow && lane == 0) { strow[0] = mean; strow[1] = rstd; }
#pragma unroll
    for (int j = 0; j < 4; ++j) { const int c = (lane + 64 * j) * 8; float x[8];
#pragma unroll
        for (int i = 0; i < 4; ++i) { x[i] = R.v[j][i] * rstd * Gp[j][0][i] + Bp[j][0][i]; x[4 + i] = R.v[j][4 + i] * rstd * Gp[j][1][i] + Bp[j][1][i]; }
        if (xf) { *(f32x4*)(xf + c) = (f32x4){x[0], x[1], x[2], x[3]}; *(f32x4*)(xf + c + 4) = (f32x4){x[4], x[5], x[6], x[7]}; }
        if (hrow) { v4u o; o.x = pk2(x[0], x[1]); o.y = pk2(x[2], x[3]); o.z = pk2(x[4], x[5]); o.w = pk2(x[6], x[7]); *(v4u*)(hrow + c) = o; } }
}

typedef short bf16x8 __attribute__((ext_vector_type(8)));
typedef float f32x16 __attribute__((ext_vector_type(16)));
#define MFMA16(a, b, c) __builtin_amdgcn_mfma_f32_16x16x32_bf16((a), (b), (c), 0, 0, 0)
#define MFMA32(a, b, c) __builtin_amdgcn_mfma_f32_32x32x16_bf16((a), (b), (c), 0, 0, 0)
__device__ __forceinline__ unsigned cvtpk(float lo, float hi) { unsigned r; asm volatile("v_cvt_pk_bf16_f32 %0, %1, %2" : "=v"(r) : "v"(lo), "v"(hi)); return r; }
__device__ __forceinline__ bf16x8 pack8(f32x4 a, f32x4 b) { v4u w; w.x = cvtpk(a[0], a[1]); w.y = cvtpk(a[2], a[3]); w.z = cvtpk(b[0], b[1]); w.w = cvtpk(b[2], b[3]); return __builtin_bit_cast(bf16x8, w); }
__device__ __forceinline__ int perm32i(int i) { return 8 * ((i >> 2) & 3) + 4 * (i >> 4) + (i & 3); }

constexpr int HG_T = 128, HG_NU = SEQ / HG_T  , HG_NU5 = HG_NU / 4  , HG_PITCH = 272  , HG_ARR = 128 * HG_PITCH;
constexpr float LOG2E = 1.4426950408889634f;

__device__ __forceinline__ void hg_gate(float z, float lb, float oml, float& k, float& lf2) {
    const float e = __builtin_amdgcn_exp2f(-LOG2E * fmaxf(z, -80.f)), s = __builtin_amdgcn_rcpf(1.f + e);
    k = oml * (e * s); lf2 = __builtin_amdgcn_logf(fmaxf(lb + oml * s, F_MIN));
}
__device__ __forceinline__ void hg_write_row32(LAS unsigned char* rowp  , const float (&v)[32]) {
#pragma unroll
    for (int g = 0; g < 4; ++g) { v4u w; w.x = cvtpk(v[4 * g], v[4 * g + 1]); w.y = cvtpk(v[4 * g + 2], v[4 * g + 3]); w.z = cvtpk(v[16 + 4 * g], v[16 + 4 * g + 1]); w.w = cvtpk(v[16 + 4 * g + 2], v[16 + 4 * g + 3]);
        *(LAS v4u*)(rowp + g * 16) = w; }
}

__device__ __forceinline__ int lane_id_local() { int l; asm volatile("v_mbcnt_lo_u32_b32 %0, -1, 0\n\tv_mbcnt_hi_u32_b32 %0, -1, %0" : "=v"(l)); return l; }
struct HgIn { unsigned z[16], q[16], v[16]; };
__device__ __forceinline__ void hg_load(HgIn& I, int unit, const bf16* Q, const unsigned short* Z, const bf16* VV, int wave, int lane, bool with_q) {
    const int bh = unit >> 5, sc = unit & 31, b = bh >> 3, h = bh & 7, c = wave >> 1, col = h * HD + 64 * (wave & 1) + lane;
    const size_t off = ((size_t)b * SEQ + sc * HG_T + 32 * c) * HW + col;
    Z += (size_t)b * (Z_BADD / 2);
#pragma unroll
    for (int s = 0; s < 16; ++s) { I.z[s] = (unsigned)Z[off + (size_t)(2 * s) * HW] | ((unsigned)Z[off + (size_t)(2 * s + 1) * HW] << 16);
        I.v[s] = (unsigned)VV[off + (size_t)(2 * s) * HW] | ((unsigned)VV[off + (size_t)(2 * s + 1) * HW] << 16);
        if (with_q) I.q[s] = (unsigned)Q[off + (size_t)(2 * s) * HW] | ((unsigned)Q[off + (size_t)(2 * s + 1) * HW] << 16); }
}
__device__ __forceinline__ unsigned short hg_get(const unsigned (&a)[16], int s) { return (unsigned short)((s & 1) ? (a[s >> 1] >> 16) : (a[s >> 1] & 0xffffu)); }
struct HgW { v4u z[4], q[4], v[4]; };
__device__ __forceinline__ void hg_loadw(HgW& W, int unit, const bf16* Q, const unsigned short* Z, const bf16* VV, int wave, int lane, bool with_q) {
    const int bh = unit >> 5, sc = unit & 31, b = bh >> 3, h = bh & 7, tid = wave * 64 + lane;
    Z += (size_t)b * (Z_BADD / 2);
    const size_t base = ((size_t)b * SEQ + sc * HG_T) * HW + h * HD;
#pragma unroll
    for (int k = 0; k < 4; ++k) { const int p = tid + 512 * k; const size_t o = base + (size_t)(p >> 4) * HW + (p & 15) * 8;
        W.z[k] = *(const v4u*)(Z + o); W.v[k] = *(const v4u*)(VV + o); if (with_q) W.q[k] = *(const v4u*)(Q + o); }
}
template <bool BAR2> __device__ __forceinline__ void hg_unstage(HgIn& I, const HgW& W, LAS unsigned char* lds, int wave, int lane, bool with_q) {
    const int tid = wave * 64 + lane;
#pragma unroll
    for (int k = 0; k < 4; ++k) { const int p = tid + 512 * k, o = (p >> 4) * HG_PITCH + (p & 15) * 16;
        *(LAS v4u*)(lds + o) = W.z[k]; *(LAS v4u*)(lds + HG_ARR + o) = W.v[k]; if (with_q) *(LAS v4u*)(lds + 2 * HG_ARR + o) = W.q[k]; }
    LDS_WAIT(); __syncthreads();
    const int c = wave >> 1, d = 64 * (wave & 1) + lane;
#pragma unroll
    for (int s = 0; s < 16; ++s) { const int o0 = (32 * c + 2 * s) * HG_PITCH + d * 2, o1 = o0 + HG_PITCH;
        I.z[s] = (unsigned)*(const LAS unsigned short*)(lds + o0) | ((unsigned)*(const LAS unsigned short*)(lds + o1) << 16);
        I.v[s] = (unsigned)*(const LAS unsigned short*)(lds + HG_ARR + o0) | ((unsigned)*(const LAS unsigned short*)(lds + HG_ARR + o1) << 16);
        if (with_q) I.q[s] = (unsigned)*(const LAS unsigned short*)(lds + 2 * HG_ARR + o0) | ((unsigned)*(const LAS unsigned short*)(lds + 2 * HG_ARR + o1) << 16); }
    if (BAR2) { LDS_WAIT(); __syncthreads(); }
}
__device__ __forceinline__ void hgrnA_unit(HgW& W, int nxt, int unit, const unsigned short* Z, const bf16* VV, const float* lbl, int l, f32x4 (&SA)[8], float& gsum, bool last_sub, int unit5, float* SLOC, float* GTOT, LAS unsigned char* lds, int wave, int lane_) {
    const int lane = lane_id_local();
    const int bh = unit >> 5, sc = unit & 31, b = bh >> 3, h = bh & 7;
    const int c = wave >> 1, d = 64 * (wave & 1) + lane, col = h * HD + d;
    const float lb = lower_bound_of(lbl, l, col), oml = 1.f - lb;
    HgIn I; hg_unstage<false>(I, W, lds + 2 * HG_ARR + 4096, wave, lane, false);
    const size_t row0 = (size_t)b * SEQ + sc * HG_T;
    LAS unsigned char* KT = lds; LAS unsigned char* VT = lds + HG_ARR; LAS float* TOT = (LAS float*)(lds + 2 * HG_ARR); LAS float* GS = TOT + 512;
    float cs[32], kk[32]; float run = 0.f;
    {
#pragma unroll
      for (int s = 0; s < 32; ++s) { float lf2; hg_gate((float)__builtin_bit_cast(_Float16, hg_get(I.z, s)), lb, oml, kk[s], lf2); run += lf2; cs[s] = run; } }
    TOT[c * 128 + d] = run;
    { float vv[32];
#pragma unroll
      for (int s = 0; s < 32; ++s) vv[s] = bf2f(hg_get(I.v, s));
      hg_write_row32(VT + d * HG_PITCH + 64 * c, vv); }
    if (nxt >= 0) hg_loadw(W, nxt, nullptr, Z, VV, wave, lane, false);
    LDS_WAIT(); __syncthreads();
    float suf = 0.f, tot = 0.f;
#pragma unroll
    for (int cc = 0; cc < 4; ++cc) { const float t = TOT[cc * 128 + d]; tot += t; if (cc > c) suf += t; }
#pragma unroll
    for (int s = 0; s < 32; ++s) kk[s] *= __builtin_amdgcn_exp2f(suf + run - cs[s]);
    hg_write_row32(KT + d * HG_PITCH + 64 * c, kk);
    if (c == 0) GS[d] = __builtin_amdgcn_exp2f(tot);
    gsum += tot;
    LDS_WAIT(); __syncthreads();
    const int g = lane >> 4, li = lane & 15;
    f32x4 acc[8];
#pragma unroll
    for (int a = 0; a < 8; ++a) acc[a] = (f32x4){0.f, 0.f, 0.f, 0.f};
#pragma unroll
    for (int ks = 0; ks < 4; ++ks) { const bf16x8 bfr = *(const LAS bf16x8*)(VT + (16 * wave + li) * HG_PITCH + (32 * ks + 8 * g) * 2);
#pragma unroll
        for (int a = 0; a < 8; ++a) { const bf16x8 afr = *(const LAS bf16x8*)(KT + (16 * a + li) * HG_PITCH + (32 * ks + 8 * g) * 2); acc[a] = MFMA16(afr, bfr, acc[a]); } }
#pragma unroll
    for (int a = 0; a < 8; ++a) { const f32x4 gv = *(const LAS f32x4*)(GS + 16 * a + 4 * g); SA[a] = SA[a] * gv + acc[a]; }
    if (last_sub) { float* so = SLOC + (size_t)unit5 * 16384 + (size_t)(unit5 >> 6) * (SL_BADD / 4) + (size_t)wave * 2048 + 4 * lane;
#pragma unroll
        for (int a = 0; a < 8; ++a) *(f32x4*)(so + a * 256) = SA[a];
        if (c == 0) GTOT[(size_t)unit5 * 128 + d] = __builtin_amdgcn_exp2f(gsum); }
    LDS_WAIT(); __syncthreads();
}
__device__ __forceinline__ void hgrnC_unit(HgW& W, int nxt, int unit, const bf16* Q, const unsigned short* Z, const bf16* VV, const bf16* SG, const float* ng  , const float* lbl, int l, f32x4 (&S)[8]  , bf16* HO, LAS unsigned char* lds, int wave, int lane_) {
    const int lane = lane_id_local();
    const int bh = unit >> 5, sc = unit & 31, b = bh >> 3, h = bh & 7;
    const float lb = lower_bound_of(lbl, l, h * HD + 64 * (wave & 1) + lane), oml = 1.f - lb;
    HgIn I; hg_unstage<true>(I, W, lds, wave, lane, true);
    const size_t row0 = (size_t)b * SEQ + sc * HG_T;
    LAS unsigned char* QT = lds; LAS unsigned char* KTt = lds + HG_ARR; LAS unsigned char* KPT = lds + 2 * HG_ARR; LAS unsigned char* VT = lds + 3 * HG_ARR;
    LAS float* GB = (LAS float*)(lds + 4 * HG_ARR); LAS float* RED = (LAS float*)(lds + 4 * HG_ARR + 2048);
    { const int c = wave >> 1, d = 64 * (wave & 1) + lane, pd = (d & ~31) + perm32i(d & 31);
      float bs[32], kk[32]; float run = 0.f;
#pragma unroll
      for (int s = 0; s < 32; ++s) { float lf2; hg_gate((float)__builtin_bit_cast(_Float16, hg_get(I.z, s)), lb, oml, kk[s], lf2); run += lf2; bs[s] = run; }
      GB[c * 128 + d] = __builtin_amdgcn_exp2f(run);
#pragma unroll
      for (int s = 0; s < 32; ++s) { const float qv = bf2f(hg_get(I.q, s));
          *(LAS unsigned short*)(QT + (32 * c + s) * HG_PITCH + pd * 2) = (unsigned short)f2bf(qv * __builtin_amdgcn_exp2f(bs[s]));
          *(LAS unsigned short*)(KTt + (32 * c + s) * HG_PITCH + pd * 2) = (unsigned short)f2bf(kk[s] * __builtin_amdgcn_exp2f(-bs[s])); }
#pragma unroll
      for (int s = 0; s < 32; ++s) kk[s] *= __builtin_amdgcn_exp2f(run - bs[s]);
      hg_write_row32(KPT + d * HG_PITCH + 64 * c, kk);
      float vv[32];
#pragma unroll
      for (int s = 0; s < 32; ++s) vv[s] = bf2f(hg_get(I.v, s));
      hg_write_row32(VT + d * HG_PITCH + 64 * c, vv); }
    if (nxt >= 0) hg_loadw(W, nxt, Q, Z, VV, wave, lane, true);
    LDS_WAIT(); __syncthreads();
    const int g = lane >> 4, li = lane & 15;
    f32x4 oT[4][2];
    v2u sgv[4][2];
#pragma unroll
    for (int c = 0; c < 4; ++c)
#pragma unroll
        for (int ti = 0; ti < 2; ++ti) sgv[c][ti] = *(const v2u*)(SG + (row0 + 32 * c + 16 * ti + li) * HW + h * HD + 16 * wave + 4 * g);
    const f32x4 ngv = *(const f32x4*)(ng + h * HD + 16 * wave + 4 * g);
#pragma unroll
    for (int c = 0; c < 4; ++c) {
        bf16x8 qf[2][4];
#pragma unroll
        for (int ti = 0; ti < 2; ++ti)
#pragma unroll
            for (int ks = 0; ks < 4; ++ks) qf[ti][ks] = *(const LAS bf16x8*)(QT + (32 * c + 16 * ti + li) * HG_PITCH + (32 * ks + 8 * g) * 2);
        f32x4 PT[2][2];
#pragma unroll
        for (int si = 0; si < 2; ++si)
#pragma unroll
            for (int ti = 0; ti < 2; ++ti) PT[si][ti] = (f32x4){0.f, 0.f, 0.f, 0.f};
#pragma unroll
        for (int ks = 0; ks < 4; ++ks)
#pragma unroll
            for (int si = 0; si < 2; ++si) { const bf16x8 kf = *(const LAS bf16x8*)(KTt + (32 * c + 16 * si + li) * HG_PITCH + (32 * ks + 8 * g) * 2);
#pragma unroll
                for (int ti = 0; ti < 2; ++ti) PT[si][ti] = MFMA16(kf, qf[ti][ks], PT[si][ti]); }
#pragma unroll
        for (int si = 0; si < 2; ++si)
#pragma unroll
            for (int ti = 0; ti < 2; ++ti)
#pragma unroll
                for (int r = 0; r < 4; ++r) if (16 * si + 4 * g + r > 16 * ti + li) PT[si][ti][r] = 0.f;
        const bf16x8 vf = *(const LAS bf16x8*)(VT + (16 * wave + li) * HG_PITCH + (32 * c + 8 * g) * 2);
#pragma unroll
        for (int ti = 0; ti < 2; ++ti) {
            f32x4 o = MFMA16(vf, pack8(PT[0][ti], PT[1][ti]), ((f32x4){0.f, 0.f, 0.f, 0.f}));
#pragma unroll
            for (int ks = 0; ks < 4; ++ks) o = MFMA16(pack8(S[2 * ks], S[2 * ks + 1]), qf[ti][ks], o);
            oT[c][ti] = o; }
#pragma unroll
        for (int a = 0; a < 8; ++a) { const f32x4 gv = *(const LAS f32x4*)(GB + c * 128 + 16 * a + 4 * g); S[a] = S[a] * gv;
            const bf16x8 kf = *(const LAS bf16x8*)(KPT + (16 * a + li) * HG_PITCH + (32 * c + 8 * g) * 2); S[a] = MFMA16(kf, vf, S[a]); }
    }
#pragma unroll
    for (int c = 0; c < 4; ++c)
#pragma unroll
        for (int ti = 0; ti < 2; ++ti) { const f32x4 o = oT[c][ti]; float p = (o[0] * o[0] + o[1] * o[1]) + (o[2] * o[2] + o[3] * o[3]); p += __shfl_xor(p, 16); p += __shfl_xor(p, 32);
            if (g == 0) RED[wave * 128 + 32 * c + 16 * ti + li] = p; }
    LDS_WAIT(); __syncthreads();
#pragma unroll
    for (int c = 0; c < 4; ++c)
#pragma unroll
        for (int ti = 0; ti < 2; ++ti) { const int t = 32 * c + 16 * ti + li; float tot = 0.f;
#pragma unroll
            for (int w = 0; w < 8; ++w) tot += RED[w * 128 + t];
            const float rinv = 1.f / sqrtf(tot * (1.f / HD) + RMS_EPS);
            const size_t offo = (row0 + t) * (size_t)(2 * HW) + h * HD + 16 * wave + 4 * g;
            const v2u sg = sgv[c][ti]; const f32x4 o = oT[c][ti];
            v2u w; w.x = pk2(o[0] * rinv * ngv[0] * __uint_as_float(sg.x << 16), o[1] * rinv * ngv[1] * __uint_as_float(sg.x & 0xffff0000u));
            w.y = pk2(o[2] * rinv * ngv[2] * __uint_as_float(sg.y << 16), o[3] * rinv * ngv[3] * __uint_as_float(sg.y & 0xffff0000u));
            *(v2u*)(HO + offo) = w; }
    LDS_WAIT(); __syncthreads();
}

__device__ __forceinline__ void kmean_wg(int it, const bf16* MK, float* KMEAN, LAS float* red, int wave, int lane) {
    const int sub = it * 2 + (wave >> 2), qr = wave & 3, h = sub & 7, n = (sub >> 3) & 15, b = sub >> 7;
    const bf16* p = MK + ((size_t)b * SEQ + n * MB_BLOCK + qr * 64) * HW + h * HD + 2 * lane;
    float s0 = 0.f, s1 = 0.f;
#pragma unroll
    for (int j = 0; j < 64; ++j) { const unsigned w = *(const unsigned*)(p + (size_t)j * HW); s0 += __uint_as_float(w << 16); s1 += __uint_as_float(w & 0xffff0000u); }
    red[wave * 128 + 2 * lane] = s0; red[wave * 128 + 2 * lane + 1] = s1;
    LDS_WAIT(); __syncthreads();
    if (qr == 0) { const int w0 = wave; float a0 = 0.f, a1 = 0.f;
#pragma unroll
        for (int q = 0; q < 4; ++q) { a0 += red[(w0 + q) * 128 + 2 * lane]; a1 += red[(w0 + q) * 128 + 2 * lane + 1]; }
        float* o = KMEAN + (((size_t)(b * NH + h) * MB_NB + n) * HD + 2 * lane); o[0] = a0 * (1.f / MB_BLOCK); o[1] = a1 * (1.f / MB_BLOCK); }
    LDS_WAIT(); __syncthreads();
}
__device__ __forceinline__ void mvt_load(int it, const bf16* MV, v4u (&w)[8], int lane) {
    const int dh = it & 1, tg = (it >> 1) & 63, h = (it >> 7) & 7, b = it >> 10;
    const bf16* src = MV + ((size_t)b * SEQ + tg * 64 + lane) * HW + h * HD + 64 * dh;
#pragma unroll
    for (int c = 0; c < 8; ++c) w[c] = *(const v4u*)(src + 8 * c);
}
__device__ __forceinline__ void mvt_finish(int it, const v4u (&wv)[8], bf16* MVT, LAS unsigned short* tile  , int lane) {
    const int dh = it & 1, tg = (it >> 1) & 63, h = (it >> 7) & 7, b = it >> 10;
    const int i16 = lane & 15, pos = (lane & ~15) + 8 * ((i16 >> 2) & 1) + 4 * (i16 >> 3) + (i16 & 3);
#pragma unroll
    for (int c = 0; c < 8; ++c) { const v4u w = wv[c]; const unsigned ww[4] = {w.x, w.y, w.z, w.w};
#pragma unroll
        for (int j = 0; j < 4; ++j) { tile[(8 * c + 2 * j) * 72 + pos] = (unsigned short)(ww[j] & 0xffffu); tile[(8 * c + 2 * j + 1) * 72 + pos] = (unsigned short)(ww[j] >> 16); } }
    LDS_WAIT(); asm volatile("" ::: "memory");
    bf16* dst = MVT + ((size_t)(b * NH + h) * HD + 64 * dh) * SEQ + (size_t)b * (MVT_BADD / 2) + tg * 64;
#pragma unroll
    for (int j = 0; j < 8; ++j) { const int dd = (lane >> 3) + 8 * j, part = lane & 7; const v4u w = *(const LAS v4u*)(tile + dd * 72 + part * 8); *(v4u*)(dst + (size_t)dd * SEQ + part * 8) = w; }
    LDS_WAIT(); asm volatile("" ::: "memory");
}
__device__ __forceinline__ void sel_item(int idx, const bf16* MQ, const float* KMEAN, unsigned* SEL) {
    const int t = idx & (SEQ - 1), bh = idx >> 12, b = bh >> 3, h = bh & 7, qb = t >> 8;
    const size_t row = (size_t)b * SEQ + t;
    unsigned mask = 0u;
    if (qb > 0) {
        float q[HD];
        const bf16* qp = MQ + row * HW + h * HD;
#pragma unroll
        for (int c = 0; c < 16; ++c) { const v4u w = *(const v4u*)(qp + c * 8);
            q[c * 8 + 0] = __uint_as_float(w.x << 16); q[c * 8 + 1] = __uint_as_float(w.x & 0xffff0000u); q[c * 8 + 2] = __uint_as_float(w.y << 16); q[c * 8 + 3] = __uint_as_float(w.y & 0xffff0000u);
            q[c * 8 + 4] = __uint_as_float(w.z << 16); q[c * 8 + 5] = __uint_as_float(w.z & 0xffff0000u); q[c * 8 + 6] = __uint_as_float(w.w << 16); q[c * 8 + 7] = __uint_as_float(w.w & 0xffff0000u); }
        const float* km = KMEAN + (size_t)(b * NH + h) * MB_NB * HD;
        float g0 = -INFINITY, g1 = -INFINITY, g2 = -INFINITY; int i0 = -1, i1 = -1, i2 = -1;
        for (int n = 0; n < qb; ++n) {
            float s = 0.f;
#pragma unroll
            for (int d = 0; d < HD; ++d) s += q[d] * km[n * HD + d];
            if (s > g0) { g2 = g1; i2 = i1; g1 = g0; i1 = i0; g0 = s; i0 = n; }
            else if (s > g1) { g2 = g1; i2 = i1; g1 = s; i1 = n; }
            else if (s > g2) { g2 = s; i2 = n; }
        }
        if (i0 >= 0) mask |= 1u << i0; if (i1 >= 0) mask |= 1u << i1; if (i2 >= 0) mask |= 1u << i2;
    }
    SEL[row * NH + h] = mask;
}
constexpr int MB_KB = 64 * 272, MB_VB = 128 * 144;
__device__ __forceinline__ void moba_unit(int bh, int qb, bool desc, const bf16* MQ, const bf16* MK, const bf16* MVT, const float* KMEAN, bf16* MO, LAS unsigned char* lds, int wave, int lane) {
    const int b = bh >> 3, h = bh & 7, tid = wave * 64 + lane, ql = lane & 31, hh = lane >> 5;
    const size_t rowq = (size_t)b * SEQ + qb * MB_BLOCK + wave * 32 + ql;
    bf16x8 qf[8];
#pragma unroll
    for (int ks = 0; ks < 8; ++ks) qf[ks] = *(const bf16x8*)(MQ + rowq * HW + h * HD + 16 * ks + 8 * hh);
    LAS unsigned char* KB = lds; LAS unsigned char* VB = lds + 2 * MB_KB;
    const bf16* kbase = MK + (size_t)b * SEQ * HW + h * HD; const bf16* vbase = MVT + (size_t)(b * NH + h) * HD * SEQ + (size_t)b * (MVT_BADD / 2);
    v4u kreg[2], vreg[2];
#define MB_PAST(i) (desc ? qb - 1 - (((i) - 4) >> 2) : (((i) - 4) >> 2))
#define MB_LOAD(i) do { const int blk_ = ((i) < 4) ? qb : MB_PAST(i); const int key0_ = blk_ * MB_BLOCK + ((i) & 3) * 64; \
        _Pragma("unroll") for (int j_ = 0; j_ < 2; ++j_) { const int id_ = tid + 512 * j_; kreg[j_] = *(const v4u*)(kbase + (size_t)(key0_ + (id_ >> 4)) * HW + (id_ & 15) * 8); \
            vreg[j_] = *(const v4u*)(vbase + (size_t)(id_ >> 3) * SEQ + key0_ + (id_ & 7) * 8); } } while (0)
#define MB_STORE(buf) do { _Pragma("unroll") for (int j_ = 0; j_ < 2; ++j_) { const int id_ = tid + 512 * j_; *(LAS v4u*)(KB + (buf) * MB_KB + (id_ >> 4) * 272 + (id_ & 15) * 16) = kreg[j_]; \
            *(LAS v4u*)(VB + (buf) * MB_VB + (id_ >> 3) * 144 + (id_ & 7) * 16) = vreg[j_]; } } while (0)
    MB_LOAD(0);
    unsigned sel = 0u;
    if (qb > 0) {
        LAS float* KM = (LAS float*)(lds + 73728);
        const float* kmg = KMEAN + (size_t)bh * MB_NB * HD;
        for (int i = tid; i < qb * 32; i += 512) *(LAS f32x4*)(KM + i * 4) = *(const f32x4*)(kmg + i * 4);
        LDS_WAIT(); __syncthreads();
        float g0 = -INFINITY, g1 = -INFINITY, g2 = -INFINITY; int i0 = -1, i1 = -1, i2 = -1;
        for (int n = 0; n < qb; ++n) { float sc_ = 0.f;
#pragma unroll
            for (int ks = 0; ks < 8; ++ks) { const f32x4 ka = *(const LAS f32x4*)(KM + n * HD + 16 * ks + 8 * hh), kb = *(const LAS f32x4*)(KM + n * HD + 16 * ks + 8 * hh + 4);
                const v4u w = __builtin_bit_cast(v4u, qf[ks]);
                sc_ += __uint_as_float(w.x << 16) * ka.x + __uint_as_float(w.x & 0xffff0000u) * ka.y + __uint_as_float(w.y << 16) * ka.z + __uint_as_float(w.y & 0xffff0000u) * ka.w
                     + __uint_as_float(w.z << 16) * kb.x + __uint_as_float(w.z & 0xffff0000u) * kb.y + __uint_as_float(w.w << 16) * kb.z + __uint_as_float(w.w & 0xffff0000u) * kb.w; }
            sc_ += __shfl_xor(sc_, 32);
            if (sc_ > g0) { g2 = g1; i2 = i1; g1 = g0; i1 = i0; g0 = sc_; i0 = n; }
            else if (sc_ > g1) { g2 = g1; i2 = i1; g1 = sc_; i1 = n; }
            else if (sc_ > g2) { g2 = sc_; i2 = n; } }
        if (i0 >= 0) sel |= 1u << i0; if (i1 >= 0) sel |= 1u << i1; if (i2 >= 0) sel |= 1u << i2;
    }
    f32x16 O[4];
#pragma unroll
    for (int dt = 0; dt < 4; ++dt)
#pragma unroll
        for (int r = 0; r < 16; ++r) O[dt][r] = 0.f;
    float m_used = 0.f, lsum = 0.f;
    const int nt = 4 * (qb + 1);
    MB_STORE(0); LDS_WAIT(); __syncthreads();
    for (int i = 0; i < nt; ++i) {
        if (i + 1 < nt) MB_LOAD(i + 1);
        const LAS unsigned char* Kc = KB + (i & 1) * MB_KB; const LAS unsigned char* Vc = VB + (i & 1) * MB_VB;
#pragma unroll
        for (int mt = 0; mt < 2; ++mt) {
            if (i < 4 && (i & 3) * 64 + 32 * mt > wave * 32 + 31) continue;
            f32x16 sT;
            { const float c0 = (i < 4 || ((sel >> MB_PAST(i)) & 1u)) ? -m_used : -INFINITY;
#pragma unroll
              for (int r = 0; r < 16; ++r) sT[r] = c0; }
#pragma unroll
            for (int ks = 0; ks < 8; ++ks) { const bf16x8 kf = *(const LAS bf16x8*)(Kc + (32 * mt + ql) * 272 + (16 * ks + 8 * hh) * 2); sT = MFMA32(kf, qf[ks], sT); if ((ks & 3) == 3) asm volatile("" ::: "memory"); }
            if (i < 4) { const int qi = wave * 32 + ql - (i & 3) * 64;
#pragma unroll
                for (int r = 0; r < 16; ++r) if (32 * mt + (r & 3) + 8 * (r >> 2) + 4 * hh > qi) sT[r] = -INFINITY; }
            float rm = sT[0];
#pragma unroll
            for (int r = 1; r < 16; ++r) rm = fmaxf(rm, sT[r]);
            rm = fmaxf(rm, __shfl_xor(rm, 32));
            const bool first = (i == 0 && mt == 0);
            if (first || __any(rm > 8.f)) {
                const float dl = first ? rm : fmaxf(rm, 0.f), al = __builtin_amdgcn_exp2f(-dl); m_used += dl; lsum *= al;
#pragma unroll
                for (int r = 0; r < 16; ++r) sT[r] -= dl;
#pragma unroll
                for (int dt = 0; dt < 4; ++dt)
#pragma unroll
                    for (int r = 0; r < 16; ++r) O[dt][r] *= al; }
#pragma unroll
            for (int r = 0; r < 16; ++r) { const float pe = __builtin_amdgcn_exp2f(sT[r]); sT[r] = pe; lsum += pe; }
            bf16x8 pf[2];
#pragma unroll
            for (int s2 = 0; s2 < 2; ++s2) { v4u w; w.x = cvtpk(sT[8 * s2], sT[8 * s2 + 1]); w.y = cvtpk(sT[8 * s2 + 2], sT[8 * s2 + 3]); w.z = cvtpk(sT[8 * s2 + 4], sT[8 * s2 + 5]); w.w = cvtpk(sT[8 * s2 + 6], sT[8 * s2 + 7]);
                pf[s2] = __builtin_bit_cast(bf16x8, w); }
#pragma unroll
            for (int dt = 0; dt < 4; ++dt) {
#pragma unroll
                for (int s2 = 0; s2 < 2; ++s2) { const bf16x8 vf = *(const LAS bf16x8*)(Vc + (32 * dt + ql) * 144 + (16 * (2 * mt + s2) + 8 * hh) * 2); O[dt] = MFMA32(vf, pf[s2], O[dt]); }
                if (dt & 1) asm volatile("" ::: "memory"); }
        }
        if (i + 1 < nt) MB_STORE((i + 1) & 1);
        LDS_WAIT(); __syncthreads();
    }
#undef MB_LOAD
#undef MB_STORE
#undef MB_PAST
    const float inv = 1.f / (lsum + __shfl_xor(lsum, 32));
    bf16* op = MO + rowq * (size_t)(2 * HW) + h * HD + 4 * hh;
#pragma unroll
    for (int dt = 0; dt < 4; ++dt)
#pragma unroll
        for (int rq = 0; rq < 4; ++rq) { v2u w; w.x = pk2(O[dt][4 * rq] * inv, O[dt][4 * rq + 1] * inv); w.y = pk2(O[dt][4 * rq + 2] * inv, O[dt][4 * rq + 3] * inv); *(v2u*)(op + 32 * dt + 8 * rq) = w; }
}
#ifndef REP_P0
#define REP_P0 1
#endif
#ifndef REP_LN
#define REP_LN 1
#endif
#ifndef REP_GEMM
#define REP_GEMM 1
#endif
#ifndef REP_A
#define REP_A 1
#endif
#ifndef REP_B
#define REP_B 1
#endif
#ifndef REP_MOBA
#define REP_MOBA 1
#endif
#ifndef REP_HC
#define REP_HC 1
#endif
struct Args { const float* in[15]; float* out; unsigned char* ws; int ph_lo, ph_hi; };
#ifndef MK_N_LAUNCHES
#define MK_N_LAUNCHES 1
#endif
constexpr int N_PHASES = 3 + DEPTH * (3 + 6 + 3);

constexpr int CW_CONV = 8192 + 512;
constexpr int CW_PBAR = 16384;
constexpr int CW_GRP = 8192;
struct Pipe { int pg, lw, gp; unsigned* cnt; unsigned* tmo; };
__device__ __forceinline__ Pipe make_pipe(unsigned* ctl) { Pipe P; const int G = gridDim.x, c = blockIdx.x;
    P.pg = (c & 7) >> 1; P.lw = (c >> 3) * 2 + (c & 1); P.gp = G >> 2;
    P.cnt = ctl + CW_GRP + 64 * P.pg; P.tmo = ctl + CW_BAR + XB_TMO; return P; }
__device__ __forceinline__ void grp_barrier(const Pipe& P, unsigned& epoch) {
    asm volatile("s_waitcnt vmcnt(0)" ::: "memory");
    __syncthreads();
    ++epoch;
    if (threadIdx.x == 0) {
        __builtin_amdgcn_fence(__ATOMIC_RELEASE, "agent");
        asm volatile("s_waitcnt vmcnt(0)" ::: "memory");
        (void)__hip_atomic_fetch_add(P.cnt, 1u, __ATOMIC_RELAXED, __HIP_MEMORY_SCOPE_AGENT);
        const unsigned target = epoch * (unsigned)P.gp; unsigned sp = 0;
        while (__hip_atomic_load(P.cnt, __ATOMIC_RELAXED, __HIP_MEMORY_SCOPE_AGENT) < target) { __builtin_amdgcn_s_sleep(1);
            if ((++sp & 255u) == 0u) { if (xb_ld(P.tmo)) break; if (sp > XB_SPIN_CAP) { atomicAdd(P.tmo, 1u); break; } } }
        __builtin_amdgcn_fence(__ATOMIC_ACQUIRE, "agent");
        asm volatile("s_waitcnt vmcnt(0)" ::: "memory");
    }
    __syncthreads();
}
#define ROWX(v) (((((v) >> 3) & 1) << 11) | ((((v) >> 4) << 3) | ((v) & 7)))
#define PH_RUN (lo <= ph && ph < hi)
#ifndef REP_BAR
#define REP_BAR 1
#endif
#define PIPE_HERE const Pipe PP = make_pipe((unsigned*)(args.ws + WS_CTL)); const int pgw = PP.lw * NWAVES + wave, PNGW = PP.gp * NWAVES
#define PH_END do { if (lo <= ph && ph + 1 < hi) { if (ph < 1) xcd_barrier(bar); else xcd_barrier(pbar); } ++ph; } while (0)
template <int l, int sub>
__device__ __forceinline__ void sub_layer(const Args& args, LAS unsigned char* lds, const XcdBarrier& bar, const XcdBarrier& pbar, int lo, int hi, int wave, int lane) {
    const int tid = threadIdx.x; const int G = gridDim.x, gw = blockIdx.x * NWAVES + wave, NGW = G * NWAVES, gt = blockIdx.x * (NWAVES * 64) + tid, NGT = G * NWAVES * 64;
    unsigned char* ws = args.ws; const float* x_in = args.in[0]; const float* ln_g = args.in[4]; const float* ln_b = args.in[5]; const float* lbl = args.in[10]; const float* hg_ng = args.in[11];
    float* STATS = (float*)(ws + WS_STATS); float* MOD = (float*)(ws + WS_MOD); unsigned short* V = (unsigned short*)(ws + WS_V); bf16* H = (bf16*)(ws + WS_H); unsigned char* R = ws + WS_R;
    unsigned char* OUTS = (unsigned char*)args.out;
    unsigned char* wl = ws + WS_WTS + (size_t)l * WL_STRIDE;
    int ph = 3 + l * 12 + (sub == 0 ? 0 : (sub == 1 ? 3 : 9));

            const float* gatev = MOD + (size_t)l * BATCH * NMOD + (sub * 3 + 2) * DM;
            if (sub != 1) {
                const int f = sub >> 1;
                if (PH_RUN) {
                    pg8::Gemm g{H, (const bf16*)(wl + WO_GU) + (size_t)f * NIN * DM, MTOK, NIN, DM}; pg8::RevOrder S; S.init(MTOK, NIN, G, (int)blockIdx.x);
                    pg8::EpiGateUp E{(bf16*)(R + R_ACT), FF};
#ifndef NO_G_GU
                    pg8::gemm_phase<pg8::EpiGateUp, pg8::RevOrder, true, true>(lds, g, S, E);
#endif
                }
                PH_END;
                if (PH_RUN) {
                    pg8::Gemm g{(const bf16*)(R + R_ACT), (const bf16*)(wl + WO_D) + (size_t)f * DM * FF, MTOK, DM, FF}; pg8::StaticOrder S; S.init(MTOK, DM, G, (int)blockIdx.x);
                    constexpr bool XF = (l == 0 && sub == 0); constexpr int pli = XF ? 0 : l * NSUB + sub - 1;
                    typedef pg8::EpiResid<XF, DM, NMOD, SEQ, 1> EpiR; EpiR E{x_in, V, gatev, STATS, ln_g + (size_t)pli * DM, ln_b + (size_t)pli * DM};
#ifndef NO_G_DN
                    pg8::gemm_phase<EpiR, pg8::StaticOrder, true, true>(lds, g, S, E);
#endif
                }
                PH_END;
            } else {
                if (PH_RUN) {
                    if (l == 0) {
                        if (tid == 0) { unsigned* cv = (unsigned*)(args.ws + WS_CTL) + CW_CONV; unsigned* tmo_ = (unsigned*)(args.ws + WS_CTL) + CW_BAR + XB_TMO; unsigned sp = 0;
                            while (__hip_atomic_load(cv, __ATOMIC_RELAXED, __HIP_MEMORY_SCOPE_AGENT) < (unsigned)G) { __builtin_amdgcn_s_sleep(1);
                                if ((++sp & 255u) == 0u) { if (xb_ld(tmo_)) break; if (sp > XB_SPIN_CAP) { atomicAdd(tmo_, 1u); break; } } }
                            __builtin_amdgcn_fence(__ATOMIC_ACQUIRE, "agent"); asm volatile("s_waitcnt vmcnt(0)" ::: "memory"); }
                        __syncthreads(); }
                    pg8::Gemm g{H, (const bf16*)(wl + WO_IN), MTOK, NIN, DM}; pg8::RevOrder S; S.init(MTOK, NIN, G, (int)blockIdx.x);
                    typedef pg8::EpiInProj<R_Q, R_VV, R_SG, R_MQ, R_MK, R_MV, R_GA, R_GB, Z_BADD> EpiIP; EpiIP E{R, OUTS + DO_Z};
#ifndef NO_G_IN
                    pg8::gemm_phase<EpiIP, pg8::RevOrder, true, true>(lds, g, S, E);
#endif
                }
                PH_END;
                if (PH_RUN) { _Pragma("unroll 1") for (int rep_ = 0; rep_ < REP_A; ++rep_) { if (rep_) { VM_WAIT(); __syncthreads(); }
                  PIPE_HERE;
                  { const int bb = PP.pg;
#ifndef NO_HA
                    HgW I; if (PP.lw < NH * HG_NU5) hg_loadw(I, (bb * (NH * HG_NU5) + PP.lw) * 4, nullptr, (const unsigned short*)(OUTS + DO_Z), (const bf16*)(R + R_VV), wave, lane_id_local(), false);
#endif
                    for (int it = PP.lw; it < 64; it += PP.gp) kmean_wg(bb * 64 + it, (const bf16*)(R + R_MK), (float*)(ws + WS_KMEAN), (LAS float*)lds, wave, lane);
                    for (int it = pgw; it < NH * 64 * 2; it += 2 * PNGW) {
                        v4u wA[8], wB[8]; const bool two = it + PNGW < NH * 64 * 2;
                        mvt_load(bb * (NH * 64 * 2) + it, (const bf16*)(R + R_MV), wA, lane); if (two) mvt_load(bb * (NH * 64 * 2) + it + PNGW, (const bf16*)(R + R_MV), wB, lane);
                        mvt_finish(bb * (NH * 64 * 2) + it, wA, (bf16*)(OUTS + DO_MVT), (LAS unsigned short*)(lds + wave * 9216), lane);
                        if (two) mvt_finish(bb * (NH * 64 * 2) + it + PNGW, wB, (bf16*)(OUTS + DO_MVT), (LAS unsigned short*)(lds + wave * 9216), lane); }
                    __syncthreads();
#ifndef NO_HA
                    { const int NUB = NH * HG_NU5  ; int il = PP.lw; const unsigned short* Zp = (const unsigned short*)(OUTS + DO_Z); const bf16* Vp = (const bf16*)(R + R_VV);
#pragma unroll 1
                      for (; il < NUB; il += PP.gp) { const int u5 = bb * NUB + il; f32x4 SA[8]; float gsum = 0.f;
#pragma unroll
                          for (int a_ = 0; a_ < 8; ++a_) SA[a_] = (f32x4){0.f, 0.f, 0.f, 0.f};
#pragma unroll 1
                          for (int j = 0; j < 4; ++j) { const int nxt = (j < 3) ? u5 * 4 + j + 1 : ((il + PP.gp < NUB) ? (u5 + PP.gp) * 4 : -1);
                              hgrnA_unit(I, nxt, u5 * 4 + j, Zp, Vp, lbl, l, SA, gsum, j == 3, u5, (float*)(OUTS + DO_SL), (float*)(ws + WS_GTOT), lds, wave, lane); } } }
                  }
#endif
                } }
                PH_END;
                if (PH_RUN) {
                  PIPE_HERE;
                  { const int bb = PP.pg;
                    for (int pl = PP.lw; pl < NH * 8; pl += PP.gp) { const int bh = bb * NH + (pl & 1) * 4 + (pl >> 4), s = (pl >> 1) & 7;
#ifndef NO_MOBA2
#pragma unroll 1
                        for (int j = 0; j < 2 * REP_MOBA; ++j) moba_unit(bh, (j & 1) ? s : 15 - s, (j & 1) != 0, (const bf16*)(R + R_MQ), (const bf16*)(R + R_MK), (const bf16*)(OUTS + DO_MVT), (const float*)(ws + WS_KMEAN), (bf16*)(R + R_SLOC) + HW, lds, wave, lane);
#endif
                    }
#ifndef NO_HC
                    { HgW I; const int NUB = NH * HG_NU5; int il = PP.lw; const bf16* Qp = (const bf16*)(R + R_Q); const unsigned short* Zp = (const unsigned short*)(OUTS + DO_Z); const bf16* Vp = (const bf16*)(R + R_VV);
                      const float* SL5 = (const float*)(OUTS + DO_SL); const float* GT5 = (const float*)(ws + WS_GTOT);
                      if (il < NUB) hg_loadw(I, (bb * NUB + il) * 4, Qp, Zp, Vp, wave, lane, true);
#pragma unroll 1
                      for (; il < NUB; il += PP.gp) { const int u5 = bb * NUB + il, bh5 = u5 >> 3, seg = u5 & 7, g_ = lane >> 4;
                          f32x4 S[8];
#pragma unroll
                          for (int a_ = 0; a_ < 8; ++a_) S[a_] = (f32x4){0.f, 0.f, 0.f, 0.f};
#pragma unroll 1
                          for (int jj = 0; jj < seg; ++jj) { const float* sp = SL5 + (size_t)(bh5 * 8 + jj) * 16384 + (size_t)(bh5 >> 3) * (SL_BADD / 4) + (size_t)wave * 2048 + 4 * lane; const float* gp = GT5 + (size_t)(bh5 * 8 + jj) * 128 + 4 * g_;
#pragma unroll
                              for (int a_ = 0; a_ < 8; ++a_) { const f32x4 gv = *(const f32x4*)(gp + 16 * a_); const f32x4 t_ = *(const f32x4*)(sp + a_ * 256);
                                  S[a_] = S[a_] * gv + t_; } }
#pragma unroll 1
                          for (int j = 0; j < 4; ++j) { const int nxt = (j < 3) ? u5 * 4 + j + 1 : ((il + PP.gp < NUB) ? (u5 + PP.gp) * 4 : -1);
                              hgrnC_unit(I, nxt, u5 * 4 + j, Qp, Zp, Vp, (const bf16*)(R + R_SG), hg_ng + l * HW, lbl, l, S, (bf16*)(R + R_SLOC), lds, wave, lane); } } }
#endif
                }
                PH_END;
                if (PH_RUN) {
                    { pg8::Gemm g{(const bf16*)(R + R_SLOC), (const bf16*)(wl + WO_A), MTOK, DM, 2 * HW}; pg8::StaticOrder S; S.init(MTOK, DM, G, (int)blockIdx.x);
                      pg8::EpiMerge E{(const bf16*)(R + R_GA), (const bf16*)(R + R_GB), (bf16*)(R + R_Z), DM};
                      pg8::gemm_phase<pg8::EpiMerge, pg8::StaticOrder, true, true>(lds, g, S, E);
                    }
                }
                PH_END;
                if (PH_RUN) {
                    pg8::Gemm g{(const bf16*)(R + R_Z), (const bf16*)(wl + WO_O), MTOK, DM, DM}; pg8::StaticOrder S; S.init(MTOK, DM, G, (int)blockIdx.x);
                    constexpr int pli = l * NSUB + sub - 1; typedef pg8::EpiResid<false, DM, NMOD, SEQ, 0> EpiR; EpiR E{x_in, V, gatev, STATS, ln_g + (size_t)pli * DM, ln_b + (size_t)pli * DM};
#ifndef NO_G_OUT
                    pg8::gemm_phase<EpiR, pg8::StaticOrder, true, true>(lds, g, S, E);
#endif
                  }
                }
                PH_END;
            }
            if (PH_RUN) { _Pragma("unroll 1") for (int rep_ = 0; rep_ < REP_LN; ++rep_) { if (rep_) { VM_WAIT(); __syncthreads(); }
                const bool last = (l == DEPTH - 1 && sub == NSUB - 1);
                const int nl = (sub == NSUB - 1) ? l + 1 : l, nsub = (sub == NSUB - 1) ? 0 : sub + 1;
                const float* g_ = ln_g + (size_t)(l * NSUB + sub) * DM; const float* b_ = ln_b + (size_t)(l * NSUB + sub) * DM;
                PIPE_HERE;
                const int bb = PP.pg;
                const float* md = last ? MOD : MOD + ((size_t)nl * BATCH + bb) * NMOD + (nsub * 3) * DM;
                f32x4 Gp[4][2], Bp[4][2];
#pragma unroll
                for (int j = 0; j < 4; ++j)
#pragma unroll
                    for (int e = 0; e < 2; ++e) { const int c = (lane + 64 * j) * 8 + 4 * e; const f32x4 gg = *(const f32x4*)(g_ + c), bbv = *(const f32x4*)(b_ + c);
                        if (last) { Gp[j][e] = gg; Bp[j][e] = bbv; }
                        else { const f32x4 sc1 = *(const f32x4*)(md + DM + c) + 1.0f, sh = *(const f32x4*)(md + c); Gp[j][e] = gg * sc1; Bp[j][e] = bbv * sc1 + sh; } }
                for (int m_ = pgw; m_ < SEQ; m_ += 4 * PNGW) {
                    LnRowRegs RR[4];
#pragma unroll
                    for (int q_ = 0; q_ < 4; ++q_) if (m_ + q_ * PNGW < SEQ) ln_row_load(RR[q_], V + (size_t)(bb * SEQ + ROWX(m_ + q_ * PNGW)) * DM, lane);
#pragma unroll
                    for (int q_ = 0; q_ < 4; ++q_) if (m_ + q_ * PNGW < SEQ) { const int m = bb * SEQ + ROWX(m_ + q_ * PNGW);
                        ln_row_finish_pc(RR[q_], last ? (float*)nullptr : STATS + 2 * (size_t)m, last ? args.out + (size_t)m * DM : (float*)nullptr, last ? (bf16*)nullptr : H + (size_t)m * DM, Gp, Bp, lane); } }
            } }
            PH_END;

}
__global__ void __launch_bounds__(NWAVES * 64, 2) fwd_kernel(Args args) {
    extern __shared__ __attribute__((aligned(16))) unsigned char lds_raw[];
    LAS unsigned char* lds = (LAS unsigned char*)lds_raw;
    volatile LAS unsigned* MISC = (volatile LAS unsigned*)(lds + MISC_OFF);
    const int tid = threadIdx.x, lane = tid & 63, wave = __builtin_amdgcn_readfirstlane(tid >> 6);
    const int G = gridDim.x, gw = blockIdx.x * NWAVES + wave, NGW = G * NWAVES, gt = blockIdx.x * (NWAVES * 64) + tid, NGT = G * NWAVES * 64;
    unsigned char* ws = args.ws;
    for (int u = tid; u < 128; u += NWAVES * 64) MISC[u] = 0u;
    __syncthreads();
    const int lo = args.ph_lo, hi = args.ph_hi;
    XcdBarrier bar; bar.bar = (unsigned*)(ws + WS_CTL) + CW_BAR; bar.x = 0; bar.st = nullptr; bar.gsize = gridDim.x;
    XcdBarrier pbar = bar;
    if (hi - lo > 1) { bar = xcd_barrier_post((unsigned*)(ws + WS_CTL) + CW_BAR, MISC + 8, gridDim.x);
        pbar = xcd_barrier_post((unsigned*)(ws + WS_CTL) + CW_PBAR + 4096 * (((int)blockIdx.x & 7) >> 1), MISC + 10, gridDim.x >> 2); }
    int ph = 0;

    const float* x_in = args.in[0]; const float* c_in = args.in[1]; const float* ada_w = args.in[2]; const float* ada_b = args.in[3];
    const float* ln_g = args.in[4]; const float* ln_b = args.in[5]; const float* lbl = args.in[10]; const float* hg_ng = args.in[11];
    float* X = args.out;
    float* MOD = (float*)(ws + WS_MOD); float* MODP = (float*)(ws + WS_MODP);
    float* V = (float*)(ws + WS_V); bf16* H = (bf16*)(ws + WS_H);
    unsigned char* R = ws + WS_R;

    if (PH_RUN) { _Pragma("unroll 1") for (int rep_ = 0; rep_ < REP_P0; ++rep_) { if (rep_) { VM_WAIT(); __syncthreads(); }
        LAS float* condT = (LAS float*)lds;
        for (int i = tid; i < BATCH * DM; i += NWAVES * 64) { const int b = i / DM, k = i % DM; condT[k * 4 + b] = silu_f(c_in[i]); }
        __syncthreads();
        for (int it = gw; it < 144 * 16; it += NGW) adaln_item(it, ada_w, MODP, condT, lane);
        __syncthreads();
        LAS float* scr = (LAS float*)(lds + wave * 16640);
        for (int it = gw; it < 5632 + 2816; it += NGW) { const int r = it < 5632 ? it : it - 5632 + CV_GU;
            convert_item(r, args.in[6], args.in[7], args.in[8], args.in[9], args.in[12], args.in[13], args.in[14], ws + WS_WTS, scr, lane); }
    } }
    PH_END;
    if (PH_RUN) { _Pragma("unroll 1") for (int rep_ = 0; rep_ < REP_LN; ++rep_) { if (rep_) { VM_WAIT(); __syncthreads(); }
        PIPE_HERE;
        {
            constexpr int NA = CV_IN + CV_A + CV_B + CV_O  , NB_ = 5632, NC_ = 2816, NREST = NA + NB_ + NC_ + CV_LAYER;
            const int lo_[5] = {0, (NREST * 19) / 100, (NREST * 42) / 100, (NREST * 69) / 100, NREST};
            const int r0 = PP.pg == 0 ? lo_[0] : PP.pg == 1 ? lo_[1] : PP.pg == 2 ? lo_[2] : lo_[3], r1 = PP.pg == 0 ? lo_[1] : PP.pg == 1 ? lo_[2] : PP.pg == 2 ? lo_[3] : lo_[4];
            LAS float* scr = (LAS float*)(lds + wave * 16640);
            for (int r = r0 + pgw; r < r1; r += PNGW) { int it;
                if (r < NA) it = CV_GU + CV_D + r; else if (r < NA + NB_) it = 5632 + (r - NA); else if (r < NA + NB_ + NC_) it = CV_GU + 2816 + (r - NA - NB_); else it = CV_LAYER + (r - NA - NB_ - NC_);
                convert_item(it, args.in[6], args.in[7], args.in[8], args.in[9], args.in[12], args.in[13], args.in[14], ws + WS_WTS, scr, lane); }
            asm volatile("s_waitcnt vmcnt(0)" ::: "memory"); __syncthreads();
            if (tid == 0) { __builtin_amdgcn_fence(__ATOMIC_RELEASE, "agent"); asm volatile("s_waitcnt vmcnt(0)" ::: "memory");
                (void)__hip_atomic_fetch_add((unsigned*)(ws + WS_CTL) + CW_CONV, 1u, __ATOMIC_RELAXED, __HIP_MEMORY_SCOPE_AGENT); }
        }
        {
            const int bb = PP.pg, PNT = PP.gp * NWAVES * 64;
            for (int i = PP.lw * (NWAVES * 64) + tid; i < DEPTH * NMOD; i += PNT) { const int l = i / NMOD, j = i % NMOD;
                float s = ada_b[l * NMOD + j];
#pragma unroll
                for (int ks = 0; ks < 16; ++ks) s += MODP[(size_t)(ks * 4 + bb) * (DEPTH * NMOD) + l * NMOD + j];
                MOD[((size_t)l * BATCH + bb) * NMOD + j] = s; } }
    } }
    PH_END;
    if (PH_RUN) { _Pragma("unroll 1") for (int rep_ = 0; rep_ < REP_LN; ++rep_) { if (rep_) { VM_WAIT(); __syncthreads(); }
        PIPE_HERE;
        const int bb = PP.pg; const float* md = MOD + (size_t)bb * NMOD;
        f32x4 sc1[8], shv[8];
#pragma unroll
        for (int j = 0; j < 8; ++j) { const int c = (lane + 64 * (j >> 1)) * 8 + 4 * (j & 1); sc1[j] = *(const f32x4*)(md + DM + c) + 1.0f; shv[j] = *(const f32x4*)(md + c); }
        for (int m_ = pgw; m_ < SEQ; m_ += 4 * PNGW) {
            f32x4 xr[4][8];
#pragma unroll
            for (int q_ = 0; q_ < 4; ++q_) if (m_ + q_ * PNGW < SEQ) {
#pragma unroll
                for (int j = 0; j < 8; ++j) xr[q_][j] = *(const f32x4*)(x_in + (size_t)(bb * SEQ + ROWX(m_ + q_ * PNGW)) * DM + (lane + 64 * (j >> 1)) * 8 + 4 * (j & 1)); }
#pragma unroll
            for (int q_ = 0; q_ < 4; ++q_) if (m_ + q_ * PNGW < SEQ) { bf16* hrow = H + (size_t)(bb * SEQ + ROWX(m_ + q_ * PNGW)) * DM;
#pragma unroll
                for (int j = 0; j < 4; ++j) { const int c = (lane + 64 * j) * 8;
                    const f32x4 h0 = xr[q_][2 * j] * sc1[2 * j] + shv[2 * j], h1 = xr[q_][2 * j + 1] * sc1[2 * j + 1] + shv[2 * j + 1];
                    v4u o; o.x = pk2(h0.x, h0.y); o.y = pk2(h0.z, h0.w); o.z = pk2(h1.x, h1.y); o.w = pk2(h1.z, h1.w); *(v4u*)(hrow + c) = o; } } }
    } }
    PH_END;

    sub_layer<0, 0>(args, lds, bar, pbar, lo, hi, wave, lane); sub_layer<0, 1>(args, lds, bar, pbar, lo, hi, wave, lane); sub_layer<0, 2>(args, lds, bar, pbar, lo, hi, wave, lane);
    sub_layer<1, 0>(args, lds, bar, pbar, lo, hi, wave, lane); sub_layer<1, 1>(args, lds, bar, pbar, lo, hi, wave, lane); sub_layer<1, 2>(args, lds, bar, pbar, lo, hi, wave, lane);
#undef PH_RUN
#undef PH_END
}

extern "C" void kernel_launch(void* const* d_in, const int* in_sizes, int n_in, void* d_out, int out_size, void* d_ws, size_t ws_size, hipStream_t stream) {
    static int grid = 0;
    if (grid == 0) {
        if (n_in != 15 || in_sizes[0] != MTOK * DM || out_size != MTOK * DM || ws_size < WS_END) { fprintf(stderr, "kernel_launch: unexpected shapes / workspace (n_in %d, ws %zu < %zu); nothing launched\n", n_in, ws_size, (size_t)WS_END); grid = -1; return; }
        int dev = 0, cus = 0, per_cu = 0;
        if (hipGetDevice(&dev) != hipSuccess || hipDeviceGetAttribute(&cus, hipDeviceAttributeMultiprocessorCount, dev) != hipSuccess) { grid = -1; return; }
        if (hipFuncSetAttribute((const void*)fwd_kernel, hipFuncAttributeMaxDynamicSharedMemorySize, LDS_BYTES) != hipSuccess) { fprintf(stderr, "kernel_launch: hipFuncSetAttribute failed\n"); grid = -1; return; }
        if (hipOccupancyMaxActiveBlocksPerMultiprocessor(&per_cu, (const void*)fwd_kernel, NWAVES * 64, LDS_BYTES) != hipSuccess || per_cu < 1) fprintf(stderr, "kernel_launch: occupancy query says %d\n", per_cu);
        (void)hipGetLastError();
        grid = cus - (cus % 8);
    }
    if (grid < 0) return;
    if (hipMemsetAsync((char*)d_ws + WS_CTL, 0, CTL_ZERO_BYTES, stream) != hipSuccess) return;
    Args a{};
    for (int i = 0; i < 15; ++i) a.in[i] = (const float*)d_in[i];
    a.out = (float*)d_out; a.ws = (unsigned char*)d_ws;
#if MK_N_LAUNCHES == 1
    a.ph_lo = 0; a.ph_hi = N_PHASES;
    hipLaunchKernelGGL(fwd_kernel, dim3(grid), dim3(NWAVES * 64), LDS_BYTES, stream, a);
#else
    for (int p = 0; p < N_PHASES; ++p) { a.ph_lo = p; a.ph_hi = p + 1; hipLaunchKernelGGL(fwd_kernel, dim3(grid), dim3(NWAVES * 64), LDS_BYTES, stream, a); }
#endif
}
```

```cpp
#include <hip/hip_runtime.h>
#include <cstdio>
#include <cstdint>
#include <cmath>
#ifndef PG8_UNIT_REP
#define PG8_UNIT_REP 1
#endif
namespace pg8 {
#define PG8_LAS __attribute__((address_space(3)))
typedef unsigned short bf16_t;
typedef short bf16x8 __attribute__((ext_vector_type(8)));
typedef float f32x4 __attribute__((ext_vector_type(4)));
typedef unsigned u32x4 __attribute__((ext_vector_type(4)));
constexpr int BM = 256, BK = 64, HALF = 128, HTB = HALF * BK * 2  , STAGE_BYTES = 8 * HTB, NXCD = 8, WGM = 8;

__host__ __device__ __forceinline__ int lds_byte(int r, int c) { const int st = (r >> 4) * 2 + (c >> 5), rr = r & 15, cc = c & 31, ob = rr * 64 + cc * 2; return st * 1024 + (ob ^ (((ob >> 9) & 1) << 5)); }
__host__ __device__ __forceinline__ void stage_rc(int b, int& R, int& C) { const int st = b / 1024, sb = b % 1024, swz = sb ^ (((sb >> 9) & 1) << 5); R = (st >> 1) * 16 + swz / 64; C = (st & 1) * 32 + (swz % 64) / 2; }
__host__ __device__ __forceinline__ int perm32(int rho) { const int n = rho >> 4, i = rho & 15; return 8 * (i >> 2) + 4 * n + (i & 3); }

struct Unit { int pm, pn; };
struct Gemm { const bf16_t* A; const bf16_t* Bt; int M, N, K; };

struct StaticOrder {
    int nM, nN, nwg, G, c;
    __host__ __device__ void init(int M, int N, int G_, int c_) { nM = M / BM; nN = N / BM; nwg = nM * nN; G = G_; c = c_; }
    __host__ __device__ bool next(int i, Unit& u) const {
        const long L = (long)(i / PG8_UNIT_REP) * G + c; if (L >= nwg) return false;
        int wgid = (int)L; { const int q = nwg / NXCD, r = nwg % NXCD, xcd = wgid % NXCD, off = wgid / NXCD; wgid = (xcd < r ? xcd * (q + 1) : r * (q + 1) + (xcd - r) * q) + off; }
        const int nig = WGM * nN, gid = wgid / nig, fm = gid * WGM, gsz = (nM - fm) < WGM ? (nM - fm) : WGM;
        u.pm = fm + ((wgid % nig) % gsz); u.pn = (wgid % nig) / gsz; return true;
    }
    __device__ __forceinline__ void a_ready(const Unit&) const {}
    __device__ __forceinline__ void done(const Unit&) const {}
};
__device__ __forceinline__ unsigned cvt_pk_bf16(float lo, float hi) { unsigned r; asm volatile("v_cvt_pk_bf16_f32 %0, %1, %2" : "=v"(r) : "v"(lo), "v"(hi)); return r; }
typedef float f32x2 __attribute__((ext_vector_type(2)));
__device__ __forceinline__ float silu_f(float v) { return v * __builtin_amdgcn_rcpf(1.f + __builtin_amdgcn_exp2f(-1.4426950408889634f * v)); }
__device__ __forceinline__ float sigm_f(float v) { return __builtin_amdgcn_rcpf(1.f + __builtin_amdgcn_exp2f(-1.4426950408889634f * v)); }
__device__ __forceinline__ float bf_lo(unsigned w) { return __uint_as_float(w << 16); }
__device__ __forceinline__ float bf_hi(unsigned w) { return __uint_as_float(w & 0xffff0000u); }

typedef _Float16 h2_t __attribute__((ext_vector_type(2)));
__device__ __forceinline__ unsigned pk_h2(float a, float b) { h2_t v = {(_Float16)a, (_Float16)b}; return __builtin_bit_cast(unsigned, v); }
__device__ __forceinline__ float h_lo(unsigned w) { return (float)__builtin_bit_cast(h2_t, w).x; }
__device__ __forceinline__ float h_hi(unsigned w) { return (float)__builtin_bit_cast(h2_t, w).y; }
struct EpiGateUp {
    static constexpr bool PERM = true, AFTER_DRAIN = false; static constexpr int MID_T = -1;
    bf16_t* O; int ldc;
    __device__ __forceinline__ void operator()(const f32x4 (&acc)[2][2][4][2], const Unit& u, int wr, int wc, int fr, int fq) const {
        const int row0 = u.pm * BM + wr * 64 + fr, col0 = u.pn * HALF + wc * 32 + 8 * fq;
#pragma unroll
        for (int ai = 0; ai < 2; ++ai)
#pragma unroll
            for (int m = 0; m < 4; ++m) { bf16_t* rowp = O + (size_t)(row0 + ai * HALF + m * 16) * ldc + col0;
                const f32x4 g0 = acc[ai][0][m][0], g1 = acc[ai][0][m][1], u0 = acc[ai][1][m][0], u1 = acc[ai][1][m][1];
                f32x4 a0, a1;
#pragma unroll
                for (int j = 0; j < 4; ++j) { a0[j] = silu_f(g0[j]) * u0[j]; a1[j] = silu_f(g1[j]) * u1[j]; }
                u32x4 w; w.x = cvt_pk_bf16(a0[0], a0[1]); w.y = cvt_pk_bf16(a0[2], a0[3]); w.z = cvt_pk_bf16(a1[0], a1[1]); w.w = cvt_pk_bf16(a1[2], a1[3]);
                *(u32x4*)rowp = w; }
    }
};

template <size_t oQ, size_t oV, size_t oSG, size_t oMQ, size_t oMK, size_t oMV, size_t oGA, size_t oGB, size_t zbadd> struct EpiInProj {
    static constexpr bool PERM = true, AFTER_DRAIN = false; static constexpr int MID_T = -1;
    static constexpr float qscale = 0.08838834764831845f * 1.4426950408889634f;
    static constexpr size_t oZ = 0;
    unsigned char* R;
    unsigned char* ZB;
    __device__ __forceinline__ void operator()(const f32x4 (&acc)[2][2][4][2], const Unit& u, int wr, int wc, int fr, int fq) const {
        const int row0 = u.pm * BM + wr * 64 + fr; const int pn = u.pn;
        int mode = 0, ld = 1024, ct = pn & 3; size_t off = 0;
        if (pn < 28) { const int t = pn >> 2;
            if (t == 0) { off = oQ; mode = 1; } else if (t == 1) { off = oZ; mode = 3; } else if (t == 2) { off = oV; } else if (t == 3) { off = oSG; mode = 1; }
            else if (t == 4) { off = oMQ; mode = 4; } else if (t == 5) { off = oMK; } else { off = oMV; } }
        else if (pn < 36) { off = oGA; mode = 2; ld = 2048; ct = pn - 28; }
        else { off = oGB; mode = 2; ld = 2048; ct = pn - 36; }
        const int col0 = ct * BM + wc * 32 + 8 * fq;
        if (mode == 3) {
            unsigned short* base = (unsigned short*)(ZB + (size_t)(u.pm >> 4) * zbadd);
#pragma unroll
            for (int ai = 0; ai < 2; ++ai)
#pragma unroll
                for (int m = 0; m < 4; ++m) { unsigned short* rowp = base + (size_t)(row0 + ai * HALF + m * 16) * ld + col0;
#pragma unroll
                    for (int bj = 0; bj < 2; ++bj) { const f32x4 v0 = acc[ai][bj][m][0], v1 = acc[ai][bj][m][1];
                        u32x4 w; w.x = pk_h2(v0[0], v0[1]); w.y = pk_h2(v0[2], v0[3]); w.z = pk_h2(v1[0], v1[1]); w.w = pk_h2(v1[2], v1[3]); *(u32x4*)(rowp + bj * HALF) = w; } }
        } else {
            bf16_t* base = (bf16_t*)(R + off);
#pragma unroll
            for (int ai = 0; ai < 2; ++ai)
#pragma unroll
                for (int m = 0; m < 4; ++m) { bf16_t* rowp = base + (size_t)(row0 + ai * HALF + m * 16) * ld + col0;
#pragma unroll
                    for (int bj = 0; bj < 2; ++bj) { f32x4 v0 = acc[ai][bj][m][0], v1 = acc[ai][bj][m][1];
                        if (mode == 1) {
#pragma unroll
                            for (int j = 0; j < 4; ++j) { v0[j] = silu_f(v0[j]); v1[j] = silu_f(v1[j]); } }
                        else if (mode == 2) {
#pragma unroll
                            for (int j = 0; j < 4; ++j) { v0[j] = sigm_f(v0[j]); v1[j] = sigm_f(v1[j]); } }
                        else if (mode == 4) { v0 = v0 * qscale; v1 = v1 * qscale; }
                        u32x4 w; w.x = cvt_pk_bf16(v0[0], v0[1]); w.y = cvt_pk_bf16(v0[2], v0[3]); w.z = cvt_pk_bf16(v1[0], v1[1]); w.w = cvt_pk_bf16(v1[2], v1[3]);
                        *(u32x4*)(rowp + bj * HALF) = w; } }
        }
    }
};

template <bool XF32, int LDC, int GATE_BSTRIDE, int ROWS_PER_BATCH, int WGT_HALF  > struct EpiResid {
    static constexpr bool PERM = true, AFTER_DRAIN = false; static constexpr int MID_T = -1;
    static constexpr float alpha = 1.4142135623730951f, wgt = WGT_HALF ? 0.5f : 1.0f;
    const float* xf32; unsigned short* out; const float* gate;
    const float* stats; const float* lng; const float* lnb;
    __device__ __forceinline__ void operator()(const f32x4 (&acc)[2][2][4][2], const Unit& u, int wr, int wc, int fr, int fq) const {
        int z_; asm volatile("v_mov_b32 %0, 0" : "=v"(z_));
        const int row0 = u.pm * BM + wr * 64 + (fr + z_), col0 = u.pn * BM + wc * 32 + 8 * (fq + z_);
        const float* gv = gate + (size_t)((u.pm * BM) / ROWS_PER_BATCH) * GATE_BSTRIDE;
        if constexpr (!XF32) {
            f32x2 stA[4], stB[4]; u32x4 xwA[4], xwB[4]; f32x4 gmv[2], lgv[2], lbv[2];
            const unsigned ob = (unsigned)(row0 * LDC + col0) * 2u, sb = (unsigned)row0 * 8u;
#define ER_ROWS(ST, XW, ai_, bj_) do { _Pragma("unroll") for (int m = 0; m < 4; ++m) { \
                ST[m] = *(const f32x2*)((const char*)stats + (sb + (unsigned)(((ai_) * HALF + m * 16) * 8))); XW[m] = *(const u32x4*)((const char*)out + (ob + (unsigned)((((ai_) * HALF + m * 16) * LDC + (bj_) * HALF) * 2))); } } while (0)
#define ER_COLS(bj_) do { _Pragma("unroll") for (int n = 0; n < 2; ++n) { gmv[n] = (*(const f32x4*)(gv + col0 + (bj_) * HALF + n * 4) + 1.0f) * wgt; \
                lgv[n] = *(const f32x4*)(lng + col0 + (bj_) * HALF + n * 4) * alpha; lbv[n] = *(const f32x4*)(lnb + col0 + (bj_) * HALF + n * 4) * alpha; } } while (0)
#define ER_DO(ST, XW, ai_, bj_) do { _Pragma("unroll") for (int m = 0; m < 4; ++m) { const u32x4 w = XW[m]; \
                f32x4 x0 = (f32x4){h_lo(w.x), h_hi(w.x), h_lo(w.y), h_hi(w.y)}, x1 = (f32x4){h_lo(w.z), h_hi(w.z), h_lo(w.w), h_hi(w.w)}; \
                x0 = (x0 - ST[m].x) * ST[m].y * lgv[0] + lbv[0]; x1 = (x1 - ST[m].x) * ST[m].y * lgv[1] + lbv[1]; \
                const f32x4 v0 = x0 + gmv[0] * acc[ai_][bj_][m][0], v1 = x1 + gmv[1] * acc[ai_][bj_][m][1]; \
                u32x4 o; o.x = pk_h2(v0[0], v0[1]); o.y = pk_h2(v0[2], v0[3]); o.z = pk_h2(v1[0], v1[1]); o.w = pk_h2(v1[2], v1[3]); \
                *(u32x4*)((char*)out + (ob + (unsigned)((((ai_) * HALF + m * 16) * LDC + (bj_) * HALF) * 2))) = o; } } while (0)
            ER_COLS(0); ER_ROWS(stA, xwA, 0, 0);
            ER_ROWS(stB, xwB, 1, 0); ER_DO(stA, xwA, 0, 0);
            ER_ROWS(stA, xwA, 0, 1); ER_DO(stB, xwB, 1, 0);
            ER_COLS(1); ER_ROWS(stB, xwB, 1, 1); ER_DO(stA, xwA, 0, 1);
            ER_DO(stB, xwB, 1, 1);
#undef ER_ROWS
#undef ER_COLS
#undef ER_DO
        } else {
            const unsigned xo = (unsigned)(row0 * LDC + col0) * 4u, oo = (unsigned)(row0 * LDC + col0) * 2u;
            f32x4 xaA[4], xbA[4], xaB[4], xbB[4], gmv[2];
#define EX_ROWS(XA, XB, ai_, bj_) do { _Pragma("unroll") for (int m = 0; m < 4; ++m) { const unsigned o_ = xo + (unsigned)((((ai_) * HALF + m * 16) * LDC + (bj_) * HALF) * 4); \
                XA[m] = *(const f32x4*)((const char*)xf32 + o_); XB[m] = *(const f32x4*)((const char*)xf32 + o_ + 16u); } } while (0)
#define EX_COLS(bj_) do { _Pragma("unroll") for (int n = 0; n < 2; ++n) gmv[n] = (*(const f32x4*)(gv + col0 + (bj_) * HALF + n * 4) + 1.0f) * wgt; } while (0)
#define EX_DO(XA, XB, ai_, bj_) do { _Pragma("unroll") for (int m = 0; m < 4; ++m) { \
                const f32x4 v0 = XA[m] * alpha + gmv[0] * acc[ai_][bj_][m][0], v1 = XB[m] * alpha + gmv[1] * acc[ai_][bj_][m][1]; \
                u32x4 o; o.x = pk_h2(v0[0], v0[1]); o.y = pk_h2(v0[2], v0[3]); o.z = pk_h2(v1[0], v1[1]); o.w = pk_h2(v1[2], v1[3]); \
                *(u32x4*)((char*)out + (oo + (unsigned)((((ai_) * HALF + m * 16) * LDC + (bj_) * HALF) * 2))) = o; } } while (0)
            EX_COLS(0); EX_ROWS(xaA, xbA, 0, 0);
            EX_ROWS(xaB, xbB, 1, 0); EX_DO(xaA, xbA, 0, 0);
            EX_ROWS(xaA, xbA, 0, 1); EX_DO(xaB, xbB, 1, 0);
            EX_COLS(1); EX_ROWS(xaB, xbB, 1, 1); EX_DO(xaA, xbA, 0, 1);
            EX_DO(xaB, xbB, 1, 1);
#undef EX_ROWS
#undef EX_COLS
#undef EX_DO
        }
    }
};

struct EpiMerge {
    static constexpr bool PERM = true, AFTER_DRAIN = false; static constexpr int MID_T = 16;
    const bf16_t* sga; const bf16_t* sgb; bf16_t* O; int ldc;
    __device__ __forceinline__ void mid(f32x4 (&acc)[2][2][4][2], const Unit& u, int wr, int wc, int fr, int fq) const {
        int z_; asm volatile("v_mov_b32 %0, 0" : "=v"(z_));
        const int row0 = u.pm * BM + wr * 64 + fr + z_, col0 = u.pn * BM + wc * 32 + 8 * fq;
        const unsigned ob = (unsigned)(row0 * ldc + col0) * 2u;
        u32x4 gaA[4], gbA[4], gaB[4], gbB[4];
#define EM_LD(GA, GB, ai_, bj_) do { _Pragma("unroll") for (int m = 0; m < 4; ++m) { const unsigned o_ = ob + (unsigned)((((ai_) * HALF + m * 16) * ldc + (bj_) * HALF) * 2); \
            GA[m] = *(const u32x4*)((const char*)sga + o_); GB[m] = *(const u32x4*)((const char*)sgb + o_); } } while (0)
#define EM_DO(GA, GB, ai_, bj_) do { _Pragma("unroll") for (int m = 0; m < 4; ++m) { const u32x4 a = GA[m], b = GB[m]; \
            f32x4 r0 = {bf_lo(a.x) * __builtin_amdgcn_rcpf(fmaxf(bf_lo(b.x), 1e-30f)), bf_hi(a.x) * __builtin_amdgcn_rcpf(fmaxf(bf_hi(b.x), 1e-30f)), bf_lo(a.y) * __builtin_amdgcn_rcpf(fmaxf(bf_lo(b.y), 1e-30f)), bf_hi(a.y) * __builtin_amdgcn_rcpf(fmaxf(bf_hi(b.y), 1e-30f))}; \
            f32x4 r1 = {bf_lo(a.z) * __builtin_amdgcn_rcpf(fmaxf(bf_lo(b.z), 1e-30f)), bf_hi(a.z) * __builtin_amdgcn_rcpf(fmaxf(bf_hi(b.z), 1e-30f)), bf_lo(a.w) * __builtin_amdgcn_rcpf(fmaxf(bf_lo(b.w), 1e-30f)), bf_hi(a.w) * __builtin_amdgcn_rcpf(fmaxf(bf_hi(b.w), 1e-30f))}; \
            acc[ai_][bj_][m][0] = acc[ai_][bj_][m][0] * r0; acc[ai_][bj_][m][1] = acc[ai_][bj_][m][1] * r1; } } while (0)
        EM_LD(gaA, gbA, 0, 0);
        EM_LD(gaB, gbB, 0, 1); EM_DO(gaA, gbA, 0, 0);
        EM_LD(gaA, gbA, 1, 0); EM_DO(gaB, gbB, 0, 1);
        EM_LD(gaB, gbB, 1, 1); EM_DO(gaA, gbA, 1, 0);
        EM_DO(gaB, gbB, 1, 1);
#undef EM_LD
#undef EM_DO
        asm volatile("s_waitcnt vmcnt(0)" ::: "memory");
    }
    __device__ __forceinline__ void operator()(const f32x4 (&acc)[2][2][4][2], const Unit& u, int wr, int wc, int fr, int fq) const {
        int z_; asm volatile("v_mov_b32 %0, 0" : "=v"(z_));
        const int row0 = u.pm * BM + wr * 64 + (fr + z_), col0 = u.pn * BM + wc * 32 + 8 * (fq + z_);
        const unsigned ob = (unsigned)(row0 * ldc + col0) * 2u;
        u32x4 gbA[4], gbB[4];
#define EF_LD(GB, ai_, bj_) do { _Pragma("unroll") for (int m = 0; m < 4; ++m) GB[m] = *(const u32x4*)((const char*)sgb + (ob + (unsigned)((((ai_) * HALF + m * 16) * ldc + (bj_) * HALF) * 2))); } while (0)
#define EF_DO(GB, ai_, bj_) do { _Pragma("unroll") for (int m = 0; m < 4; ++m) { const u32x4 b = GB[m]; f32x4 v0 = acc[ai_][bj_][m][0], v1 = acc[ai_][bj_][m][1]; \
            v0[0] *= bf_lo(b.x); v0[1] *= bf_hi(b.x); v0[2] *= bf_lo(b.y); v0[3] *= bf_hi(b.y); v1[0] *= bf_lo(b.z); v1[1] *= bf_hi(b.z); v1[2] *= bf_lo(b.w); v1[3] *= bf_hi(b.w); \
            u32x4 w; w.x = cvt_pk_bf16(v0[0], v0[1]); w.y = cvt_pk_bf16(v0[2], v0[3]); w.z = cvt_pk_bf16(v1[0], v1[1]); w.w = cvt_pk_bf16(v1[2], v1[3]); \
            *(u32x4*)((char*)O + (ob + (unsigned)((((ai_) * HALF + m * 16) * ldc + (bj_) * HALF) * 2))) = w; } } while (0)
        EF_LD(gbA, 0, 0);
        EF_LD(gbB, 0, 1); EF_DO(gbA, 0, 0);
        EF_LD(gbA, 1, 0); EF_DO(gbB, 0, 1);
        EF_LD(gbB, 1, 1); EF_DO(gbA, 1, 0);
        EF_DO(gbB, 1, 1);
#undef EF_LD
#undef EF_DO
    }
};

struct RevOrder : StaticOrder {
    __device__ __forceinline__ bool next(int i, Unit& u) const { const bool r = StaticOrder::next(i, u); u.pn = nN - 1 - u.pn; return r; }
};
template <class Epi, class Sched, bool ALIGN_EPI = false, bool SP2 = false>
__device__ __forceinline__ void gemm_phase(PG8_LAS unsigned char* lds, const Gemm g, const Sched& S, const Epi& E) {
    const int tid = threadIdx.x, wid = __builtin_amdgcn_readfirstlane(tid >> 6), lane = tid & 63, wr = wid >> 2, wc = wid & 3, fr = lane & 15, fq = lane >> 4;
    const int K = g.K, nt = K / BK;
    unsigned voffA[2], voffB[2];
#pragma unroll
    for (int i = 0; i < 2; ++i) { int R, C; stage_rc(tid * 16 + i * 8192, R, C); const int Rb = Epi::PERM ? ((R & ~31) + perm32(R & 31)) : R;
        voffA[i] = (unsigned)(R * K + C) * 2u; voffB[i] = (unsigned)(Rb * K + C) * 2u; }
    const size_t kstep = (size_t)(BK * 2);
    const size_t hstep = (size_t)HALF * K * 2;
    const size_t tstep = 2 * hstep;
    const unsigned ldsw = (unsigned)wid * 1024u;
    const int aoff = lds_byte(wr * 64 + fr, fq * 8), boff = lds_byte(wc * 32 + fr, fq * 8);
#define PG8_SA(b, h) (((b) * 2 + (h)) * HTB)
#define PG8_SB(b, h) ((4 + (b) * 2 + (h)) * HTB)
#define PG8_STAGE(bufoff, gbase, voff) do { _Pragma("unroll") for (int _i = 0; _i < 2; ++_i) \
        __builtin_amdgcn_global_load_lds((const unsigned*)((const char*)(gbase) + (voff)[_i]), (PG8_LAS unsigned*)(lds + (bufoff) + ldsw + _i * 8192), 16, 0, 0); } while (0)
#define PG8_LDA(dst, b, h) do { _Pragma("unroll") for (int m = 0; m < 4; ++m) _Pragma("unroll") for (int k = 0; k < 2; ++k) dst[m][k] = *(const PG8_LAS bf16x8*)(lds + PG8_SA(b, h) + aoff + m * 2048 + k * 1024); } while (0)
#define PG8_LDB(dst, b, h) do { _Pragma("unroll") for (int n = 0; n < 2; ++n) _Pragma("unroll") for (int k = 0; k < 2; ++k) dst[n][k] = *(const PG8_LAS bf16x8*)(lds + PG8_SB(b, h) + boff + n * 2048 + k * 1024); } while (0)
#define PG8_MMA(ai, bj, At, Bt) do { __builtin_amdgcn_s_setprio(1); _Pragma("unroll") for (int m = 0; m < 4; ++m) _Pragma("unroll") for (int n = 0; n < 2; ++n) _Pragma("unroll") for (int k = 0; k < 2; ++k) \
        acc[ai][bj][m][n] = __builtin_amdgcn_mfma_f32_16x16x32_bf16(Bt[n][k], At[m][k], acc[ai][bj][m][n], 0, 0, 0); __builtin_amdgcn_s_setprio(0); } while (0)
#define PG8_WAIT_V(n) asm volatile("s_waitcnt vmcnt(" #n ")" ::: "memory")
#define PG8_WAIT_L(n) asm volatile("s_waitcnt lgkmcnt(" #n ")" ::: "memory")
#define PG8_BAR __builtin_amdgcn_s_barrier()
#define PG8_SCHED __builtin_amdgcn_sched_barrier(0)
    Unit cur, nxt; int ui = 0;
    if (!S.next(0, cur)) return;
    f32x4 acc[2][2][4][2];
#pragma unroll
    for (int a = 0; a < 2; ++a)
#pragma unroll
        for (int b = 0; b < 2; ++b)
#pragma unroll
            for (int m = 0; m < 4; ++m)
#pragma unroll
                for (int n = 0; n < 2; ++n) acc[a][b][m][n] = (f32x4){0.f, 0.f, 0.f, 0.f};
    bf16x8 At[4][2], B0[2][2], B1[2][2];
    const char* cA = (const char*)g.A + (size_t)cur.pm * tstep; const char* cB = (const char*)g.Bt + (size_t)cur.pn * tstep;
    S.a_ready(cur);
    if constexpr (SP2) {
        PG8_STAGE(PG8_SB(0, 0), cB, voffB); PG8_STAGE(PG8_SB(0, 1), cB + hstep, voffB); PG8_STAGE(PG8_SA(0, 0), cA, voffA); PG8_STAGE(PG8_SA(0, 1), cA + hstep, voffA);
        if (wr == 1) PG8_BAR;
        PG8_WAIT_V(2); PG8_BAR;
        PG8_STAGE(PG8_SB(1, 0), cB + kstep, voffB); PG8_STAGE(PG8_SA(1, 0), cA + kstep, voffA); PG8_STAGE(PG8_SB(1, 1), cB + hstep + kstep, voffB);
        PG8_WAIT_V(6); PG8_BAR;
    } else {
        PG8_STAGE(PG8_SB(0, 0), cB, voffB); PG8_STAGE(PG8_SA(0, 0), cA, voffA); PG8_STAGE(PG8_SB(0, 1), cB + hstep, voffB); PG8_STAGE(PG8_SA(0, 1), cA + hstep, voffA);
        if (wr == 1) PG8_BAR;
        PG8_WAIT_V(4); PG8_BAR;
        PG8_STAGE(PG8_SB(1, 0), cB + kstep, voffB); PG8_STAGE(PG8_SA(1, 0), cA + kstep, voffA); PG8_STAGE(PG8_SB(1, 1), cB + hstep + kstep, voffB);
        PG8_WAIT_V(6); PG8_BAR;
    }
    for (;;) {
        const bool has_next = S.next(ui + 1, nxt);
        const char* nA = has_next ? (const char*)g.A + (size_t)nxt.pm * tstep : cA; const char* nB = has_next ? (const char*)g.Bt + (size_t)nxt.pn * tstep : cB;
        constexpr int NSEG = Epi::MID_T >= 0 ? 2 : 1;
#pragma unroll 1
        for (int seg = 0; seg < NSEG; ++seg) {
        if constexpr (Epi::MID_T >= 0) { if (seg == 1) E.mid(acc, cur, wr, wc, fr, fq); }
        const int t_lo = (NSEG == 2 && seg == 1) ? Epi::MID_T : 0, t_hi = (NSEG == 2 && seg == 0) ? Epi::MID_T : nt;
        for (int t = t_lo; t < t_hi; t += 2) {
            const bool last = (t == nt - 2);
            const char* a1 = cA + (size_t)(t + 1) * kstep;
            const char* a2 = last ? nA : cA + (size_t)(t + 2) * kstep; const char* b2 = last ? nB : cB + (size_t)(t + 2) * kstep;
            const char* a3 = a2 + kstep; const char* b3 = b2 + kstep;
            if (last && has_next) S.a_ready(nxt);
            if constexpr (SP2) {
            PG8_LDB(B0, 0, 0); PG8_LDB(B1, 0, 1); PG8_SCHED; PG8_LDA(At, 0, 0); PG8_STAGE(PG8_SA(1, 1), a1 + hstep, voffA);
            PG8_WAIT_V(8); PG8_WAIT_L(0); PG8_BAR; PG8_MMA(0, 0, At, B0); PG8_MMA(0, 1, At, B1); PG8_BAR; PG8_SCHED;
            PG8_LDA(At, 0, 1); PG8_STAGE(PG8_SB(0, 0), b2, voffB); PG8_STAGE(PG8_SB(0, 1), b2 + hstep, voffB); PG8_STAGE(PG8_SA(0, 0), a2, voffA);
            PG8_WAIT_V(8); PG8_WAIT_L(0); PG8_BAR; PG8_MMA(1, 0, At, B0); PG8_MMA(1, 1, At, B1); PG8_BAR; PG8_SCHED;
            PG8_LDB(B0, 1, 0); PG8_LDB(B1, 1, 1); PG8_SCHED; PG8_LDA(At, 1, 0); PG8_STAGE(PG8_SA(0, 1), a2 + hstep, voffA);
            PG8_WAIT_V(8); PG8_WAIT_L(0); PG8_BAR; PG8_MMA(0, 0, At, B0); PG8_MMA(0, 1, At, B1); PG8_BAR; PG8_SCHED;
            PG8_LDA(At, 1, 1); PG8_STAGE(PG8_SB(1, 0), b3, voffB); PG8_STAGE(PG8_SB(1, 1), b3 + hstep, voffB); PG8_STAGE(PG8_SA(1, 0), a3, voffA);
            PG8_WAIT_V(8); PG8_WAIT_L(0); PG8_BAR; PG8_MMA(1, 0, At, B0); PG8_MMA(1, 1, At, B1); PG8_BAR; PG8_SCHED;
            } else {
            PG8_LDB(B0, 0, 0); PG8_SCHED; PG8_LDA(At, 0, 0); PG8_STAGE(PG8_SA(1, 1), a1 + hstep, voffA);
            PG8_WAIT_L(8); PG8_BAR; PG8_WAIT_L(0); PG8_MMA(0, 0, At, B0); PG8_BAR; PG8_SCHED;
            PG8_LDB(B1, 0, 1); PG8_STAGE(PG8_SB(0, 0), b2, voffB);
            PG8_BAR; PG8_WAIT_L(0); PG8_MMA(0, 1, At, B1); PG8_BAR;
            PG8_LDA(At, 0, 1); PG8_STAGE(PG8_SA(0, 0), a2, voffA);
            PG8_BAR; PG8_WAIT_L(0); PG8_MMA(1, 0, At, B0); PG8_BAR; PG8_SCHED;
            PG8_STAGE(PG8_SB(0, 1), b2 + hstep, voffB);
            PG8_WAIT_V(6); PG8_BAR; PG8_MMA(1, 1, At, B1); PG8_BAR;
            PG8_LDB(B0, 1, 0); PG8_SCHED; PG8_LDA(At, 1, 0); PG8_STAGE(PG8_SA(0, 1), a2 + hstep, voffA);
            PG8_WAIT_L(8); PG8_BAR; PG8_WAIT_L(0); PG8_MMA(0, 0, At, B0); PG8_BAR; PG8_SCHED;
            PG8_LDB(B1, 1, 1); PG8_STAGE(PG8_SB(1, 0), b3, voffB);
            PG8_BAR; PG8_WAIT_L(0); PG8_MMA(0, 1, At, B1); PG8_BAR;
            PG8_LDA(At, 1, 1); PG8_STAGE(PG8_SA(1, 0), a3, voffA);
            PG8_BAR; PG8_WAIT_L(0); PG8_MMA(1, 0, At, B0); PG8_BAR; PG8_SCHED;
            PG8_STAGE(PG8_SB(1, 1), b3 + hstep, voffB);
            PG8_WAIT_V(6); PG8_BAR; PG8_MMA(1, 1, At, B1); PG8_BAR;
            }
        }
        }
        if constexpr (ALIGN_EPI) { if (wr == 0) PG8_BAR; }
        if constexpr (!Epi::AFTER_DRAIN) { E(acc, cur, wr, wc, fr, fq);
#if defined(PG8_EPI_REP2)
            asm volatile("" ::: "memory"); E(acc, cur, wr, wc, fr, fq);
#endif
            S.done(cur); }
        if (!has_next) break;
#pragma unroll
        for (int a = 0; a < 2; ++a)
#pragma unroll
            for (int b = 0; b < 2; ++b)
#pragma unroll
                for (int m = 0; m < 4; ++m)
#pragma unroll
                    for (int n = 0; n < 2; ++n) acc[a][b][m][n] = (f32x4){0.f, 0.f, 0.f, 0.f};
        cur = nxt; cA = nA; cB = nB; ++ui;
        if constexpr (ALIGN_EPI) { if (wr == 1) PG8_BAR; }
    }
    PG8_WAIT_V(0);
    if constexpr (!ALIGN_EPI) { if (wr == 0) PG8_BAR; }
    PG8_BAR;
    if constexpr (Epi::AFTER_DRAIN) { E.fused(acc, cur, wr, wc, fr, fq, lds, wid, lane); S.done(cur); }
#undef PG8_SA
#undef PG8_SB
#undef PG8_STAGE
#undef PG8_LDA
#undef PG8_LDB
#undef PG8_MMA
#undef PG8_WAIT_V
#undef PG8_WAIT_L
#undef PG8_BAR
#undef PG8_SCHED
}
}
constexpr int BATCH = 4, SEQ = 4096, DM = 2048, MTOK = BATCH * SEQ, FF = 5632, NIN = 11264, HW = 1024, NH = 8, HD = 128, DEPTH = 2, NSUB = 3;
constexpr int NMOD = NSUB * 3 * DM;
constexpr float DN_ALPHA = 1.4142135623730951f;
constexpr float LN_EPS = 1e-5f, RMS_EPS = 1e-6f, F_MIN = 1e-30f;
constexpr float ATT_C2 = 0.08838834764831845f * 1.4426950408889634f;
constexpr int MB_BLOCK = 256, MB_NB = SEQ / MB_BLOCK, MB_TOPK = 3;
constexpr int NWAVES = 8;

constexpr size_t MiB = 1u << 20;
constexpr size_t WS_CTL = 0, CTL_ZERO_BYTES = 1 * MiB;
constexpr size_t WS_MOD = 1 * MiB;
constexpr size_t WS_MODP = 2 * MiB;
constexpr size_t WS_KMEAN = 12 * MiB;
constexpr size_t WS_SEL = 12 * MiB + 512 * 1024;
constexpr size_t WS_GTOT = 13 * MiB;
constexpr size_t WS_WTS = 16 * MiB, WL_STRIDE = 192 * MiB;
constexpr size_t WO_GU = 0, WO_D = 88 * MiB, WO_IN = 132 * MiB, WO_A = 176 * MiB, WO_B = 180 * MiB, WO_O = 184 * MiB;
constexpr size_t WS_V = 400 * MiB;
constexpr size_t WS_STATS = 14 * MiB;
constexpr size_t WS_H = 464 * MiB;
constexpr size_t WS_R = 528 * MiB;
constexpr size_t R_ACT = 0;
constexpr size_t R_Q = 176 * MiB, R_VV = 208 * MiB, R_SG = 240 * MiB, R_MQ = 272 * MiB, R_MK = 304 * MiB, R_MV = 336 * MiB, R_GA = 368 * MiB, R_GB = 432 * MiB, R_Z = 496 * MiB  ;
constexpr size_t R_SLOC = 560 * MiB;
constexpr size_t R_MVT = 448 * MiB;
constexpr size_t R_T = 384 * MiB;
constexpr size_t R_HO = 512 * MiB;
constexpr size_t WS_END = WS_R + 624 * MiB;
constexpr size_t DO_B = 32 * MiB, DO_Z = 0, DO_SL = 8 * MiB, DO_MVT = 12 * MiB;
constexpr size_t Z_BADD = DO_B - 8 * MiB, SL_BADD = DO_B - 4 * MiB, MVT_BADD = DO_B - 8 * MiB;

constexpr int CW_BAR = 4096;

constexpr int LDS_BYTES = 147456, MISC_OFF = LDS_BYTES - 512;

#define GAS __attribute__((address_space(1)))
#define LAS __attribute__((address_space(3)))
typedef unsigned short bf16;
typedef unsigned v4u __attribute__((ext_vector_type(4)));
typedef unsigned v2u __attribute__((ext_vector_type(2)));
typedef float f32x4 __attribute__((ext_vector_type(4)));
typedef float f32x2 __attribute__((ext_vector_type(2)));
#define LDS_WAIT() asm volatile("s_waitcnt lgkmcnt(0)" ::: "memory")
#define VM_WAIT() asm volatile("s_waitcnt vmcnt(0)" ::: "memory")
__device__ __forceinline__ unsigned f2bf(float f) { unsigned u = __builtin_bit_cast(unsigned, f); return (u + 0x7fffu + ((u >> 16) & 1u)) >> 16; }
__device__ __forceinline__ unsigned pk2(float lo, float hi) { return f2bf(lo) | (f2bf(hi) << 16); }
__device__ __forceinline__ float bf2f(bf16 v) { return __uint_as_float((unsigned)v << 16); }
__device__ __forceinline__ float wave_sum(float v) {
#pragma unroll
    for (int o = 1; o < 64; o <<= 1) v += __shfl_xor(v, o);
    return v;
}
__device__ __forceinline__ float wave_max(float v) {
#pragma unroll
    for (int o = 1; o < 64; o <<= 1) v = fmaxf(v, __shfl_xor(v, o));
    return v;
}
using pg8::silu_f; using pg8::sigm_f;
#define XB_TMO      128
#define XB_XCNT(j)  (256  + 64 * (j))
#define XB_XSUB(j)  (1280 + 64 * (j))
#define XB_XGEN(j)  (2304 + 64 * (j))
#define XB_TOP      3328
#define XB_TOPGEN   3392
#define XCD_BAR_WORDS 3456
#define XB_SPIN_CAP (1u << 18)

__device__ __forceinline__ unsigned xb_ld(unsigned* p)              { return __hip_atomic_load(p, __ATOMIC_RELAXED, __HIP_MEMORY_SCOPE_AGENT); }
__device__ __forceinline__ unsigned xb_add(unsigned* p, unsigned v) { return __hip_atomic_fetch_add(p, v, __ATOMIC_RELAXED, __HIP_MEMORY_SCOPE_AGENT); }
__device__ __forceinline__ unsigned xb_xcc_id() { return (unsigned)__builtin_amdgcn_s_getreg((3 << 11) | 20) & 0xFu; }
#define XB_SPIN(cond, bar) do { unsigned _sp = 0; while (cond) { __builtin_amdgcn_s_sleep(1); \
    if ((++_sp & 255u) == 0u) { if (xb_ld(&(bar)[XB_TMO])) break; if (_sp > XB_SPIN_CAP) { atomicAdd(&(bar)[XB_TMO], 1u); break; } } } } while (0)

struct XcdBarrier {
    unsigned* bar; unsigned x;
    unsigned gsize;
    volatile LAS unsigned* st;
};

__device__ __forceinline__ XcdBarrier xcd_barrier_post(unsigned* bar, volatile LAS unsigned* st, unsigned gsize) {
    XcdBarrier b; b.bar = bar; b.x = xb_xcc_id(); b.st = st; b.gsize = gsize;
    if (threadIdx.x == 0) (void)xb_add(&bar[XB_XCNT(b.x)], 1u);
    return b;
}
__device__ __forceinline__ void xcd_barrier_complete(unsigned* bar, unsigned x, unsigned& nloc, unsigned& nx, unsigned G) {
    unsigned sum, cnt, mine, sp = 0u;
    for (;;) {
        sum = 0u; cnt = 0u; mine = 0u;
#pragma unroll
        for (unsigned j = 0; j < 16; ++j) { const unsigned c = xb_ld(&bar[XB_XCNT(j)]); sum += c; cnt += (c > 0u) ? 1u : 0u; mine = (j == x) ? c : mine; }
        if (sum == G) break;
        __builtin_amdgcn_s_sleep(1);
        if ((++sp & 255u) == 0u) { if (xb_ld(&bar[XB_TMO])) break; if (sp > XB_SPIN_CAP) { atomicAdd(&bar[XB_TMO], 1u); break; } }
    }
    nloc = mine > 0u ? mine : 1u; nx = cnt > 0u ? cnt : 1u;
}

__device__ __forceinline__ void xcd_barrier(const XcdBarrier& b) {
    asm volatile("s_waitcnt vmcnt(0)" ::: "memory");
    __syncthreads();
    if (threadIdx.x == 0) {
        unsigned* bar = b.bar;
        __builtin_amdgcn_s_waitcnt(0);
        unsigned nloc = b.st[0], nx = b.st[1];
        if (nloc == 0u) { xcd_barrier_complete(bar, b.x, nloc, nx, b.gsize); b.st[0] = nloc; b.st[1] = nx; }
        const unsigned old = xb_add(&bar[XB_XSUB(b.x)], 1u);
        const unsigned gen = old / nloc;
        if (old + 1u == (gen + 1u) * nloc) {
            __builtin_amdgcn_fence(__ATOMIC_RELEASE, "agent");
            asm volatile("s_waitcnt vmcnt(0)" ::: "memory");
            const unsigned og = xb_add(&bar[XB_TOP], 1u);
            const unsigned tg = og / nx;
            if (og + 1u == (tg + 1u) * nx) xb_add(&bar[XB_TOPGEN], 1u);
            else XB_SPIN(xb_ld(&bar[XB_TOPGEN]) == tg, bar);
            __builtin_amdgcn_fence(__ATOMIC_ACQUIRE, "agent");
            xb_add(&bar[XB_XGEN(b.x)], 1u);
            asm volatile("s_waitcnt vmcnt(0)" ::: "memory");
        } else {
            XB_SPIN(xb_ld(&bar[XB_XGEN(b.x)]) == gen, bar);
            __builtin_amdgcn_fence(__ATOMIC_ACQUIRE, "agent");
            asm volatile("s_waitcnt vmcnt(0)" ::: "memory");
        }
    }
    __syncthreads();
}
__device__ __forceinline__ float lower_bound_of(const float* lbl, int l, int col) {
    float m = lbl[col];
#pragma unroll
    for (int j = 1; j < DEPTH; ++j) m = fmaxf(m, lbl[j * HW + col]);
    float den = 0.f, num = 0.f;
#pragma unroll
    for (int j = 0; j < DEPTH; ++j) { const float e = __expf(lbl[j * HW + col] - m); den += e; if (j >= 1 && j <= l) num += e; }
    return num / den;
}

__device__ __forceinline__ void transpose_item64(const float* W, int N, bf16* WT, int ldk, int k0, int n0, int orow0, LAS float* scr, int lane, int kdst = -1) {
    if (kdst < 0) kdst = k0;
    f32x4 v[16];
#pragma unroll
    for (int i = 0; i < 16; ++i) v[i] = __builtin_nontemporal_load((const f32x4*)(W + (size_t)(k0 + 4 * i + (lane >> 4)) * N + n0 + (lane & 15) * 4));
#pragma unroll
    for (int i = 0; i < 16; ++i) { LAS float* s = scr + (4 * i + (lane >> 4)) * 65 + (lane & 15) * 4; s[0] = v[i].x; s[1] = v[i].y; s[2] = v[i].z; s[3] = v[i].w; }
    LDS_WAIT(); asm volatile("" ::: "memory");
    const int c = lane & 7;
#pragma unroll
    for (int j = 0; j < 8; ++j) { const int n = (lane >> 3) + 8 * j; const LAS float* s = scr + (8 * c) * 65 + n;
        v4u o; o.x = pk2(s[0 * 65], s[1 * 65]); o.y = pk2(s[2 * 65], s[3 * 65]); o.z = pk2(s[4 * 65], s[5 * 65]); o.w = pk2(s[6 * 65], s[7 * 65]);
        *(v4u*)(WT + (size_t)(orow0 + n) * ldk + kdst + 8 * c) = o; }
    LDS_WAIT(); asm volatile("" ::: "memory");
}
constexpr int CV_GU = 4 * 2816, CV_D = 2 * 2816, CV_IN = 5632, CV_A = 512, CV_B = 512, CV_O = 1024, CV_LAYER = CV_GU + CV_D + CV_IN + CV_A + CV_B + CV_O;
__device__ __forceinline__ void convert_item(int it, const float* wg, const float* wu, const float* wd, const float* win, const float* wa, const float* wb, const float* wo, unsigned char* wts, LAS float* scr, int lane) {
    const int l = it / CV_LAYER; int r = it % CV_LAYER; unsigned char* wl = wts + (size_t)l * WL_STRIDE;
    if (r < CV_GU) { const int mat = r / 2816, rem = r % 2816, f = mat >> 1, isup = mat & 1, kb = rem / 88, nb = rem % 88, n0 = nb * 64;
        const float* src = (isup ? wu : wg) + (size_t)(l * 2 + f) * DM * FF;
        transpose_item64(src, FF, (bf16*)(wl + WO_GU) + (size_t)f * NIN * DM, DM, kb * 64, n0, 256 * (n0 >> 7) + (n0 & 127) + 128 * isup, scr, lane); return; }
    r -= CV_GU;
    if (r < CV_D) { const int f = r / 2816, rem = r % 2816, kb = rem / 32, nb = rem % 32;
        transpose_item64(wd + (size_t)(l * 2 + f) * FF * DM, DM, (bf16*)(wl + WO_D) + (size_t)f * DM * FF, FF, kb * 64, nb * 64, nb * 64, scr, lane); return; }
    r -= CV_D;
    if (r < CV_IN) { const int kb = r / 176, nb = r % 176;
        transpose_item64(win + (size_t)l * DM * NIN, NIN, (bf16*)(wl + WO_IN), DM, kb * 64, nb * 64, nb * 64, scr, lane); return; }
    r -= CV_IN;
    if (r < CV_A) { const int kb = r / 32, nb = r % 32;
        transpose_item64(wa + (size_t)l * HW * DM, DM, (bf16*)(wl + WO_A), 2 * HW, kb * 64, nb * 64, nb * 64, scr, lane); return; }
    r -= CV_A;
    if (r < CV_B) { const int kb = r / 32, nb = r % 32;
        transpose_item64(wb + (size_t)l * HW * DM, DM, (bf16*)(wl + WO_A), 2 * HW, kb * 64, nb * 64, nb * 64, scr, lane, HW + kb * 64); return; }
    r -= CV_B;
    { const int kb = r / 32, nb = r % 32;
        transpose_item64(wo + (size_t)l * DM * DM, DM, (bf16*)(wl + WO_O), DM, kb * 64, nb * 64, nb * 64, scr, lane); }
}
__device__ __forceinline__ void adaln_item(int it, const float* ada_w, float* modp, const LAS float* condT, int lane) {
    const int strip = it % 144, ks = it / 144, l = strip / 72, s = strip % 72;
    const float* wp = ada_w + ((size_t)l * DM + ks * 128) * NMOD + s * 256 + lane * 4;
    f32x4 a0 = {0.f, 0.f, 0.f, 0.f}, a1 = a0, a2 = a0, a3 = a0;
#pragma unroll 16
    for (int k = 0; k < 128; ++k) { const f32x4 w = __builtin_nontemporal_load((const f32x4*)(wp + (size_t)k * NMOD)); const f32x4 cd = *(const LAS f32x4*)(condT + (ks * 128 + k) * 4);
        a0 += w * cd.x; a1 += w * cd.y; a2 += w * cd.z; a3 += w * cd.w; }
    float* o = modp + (size_t)(ks * 4) * (DEPTH * NMOD) + l * NMOD + s * 256 + lane * 4;
    *(f32x4*)(o) = a0; *(f32x4*)(o + DEPTH * NMOD) = a1; *(f32x4*)(o + 2 * DEPTH * NMOD) = a2; *(f32x4*)(o + 3 * DEPTH * NMOD) = a3;
}

__device__ __forceinline__ void modulate_row(const float* xrow, bf16* hrow, const float* shift, const float* scale, int lane) {
#pragma unroll
    for (int j = 0; j < 8; ++j) { const int c = (lane + 64 * j) * 4; const f32x4 x = *(const f32x4*)(xrow + c), sc = *(const f32x4*)(scale + c), sh = *(const f32x4*)(shift + c);
        const f32x4 h = x * (sc + 1.0f) + sh; v2u o; o.x = pk2(h.x, h.y); o.y = pk2(h.z, h.w); *(v2u*)(hrow + c) = o; }
}
using pg8::pk_h2; using pg8::h_lo; using pg8::h_hi;
struct LnRowRegs { float v[4][8]; };
__device__ __forceinline__ void ln_row_load(LnRowRegs& R, const unsigned short* vrow, int lane) {
#pragma unroll
    for (int j = 0; j < 4; ++j) { const v4u w = *(const v4u*)(vrow + (lane + 64 * j) * 8);
        R.v[j][0] = h_lo(w.x); R.v[j][1] = h_hi(w.x); R.v[j][2] = h_lo(w.y); R.v[j][3] = h_hi(w.y); R.v[j][4] = h_lo(w.z); R.v[j][5] = h_hi(w.z); R.v[j][6] = h_lo(w.w); R.v[j][7] = h_hi(w.w); }
}
__device__ __forceinline__ void ln_row_finish(LnRowRegs& R, float* strow  , float* xf, bf16* hrow, const float* g, const float* bta, const float* shift, const float* scale, int lane) {
    float s = 0.f;
#pragma unroll
    for (int j = 0; j < 4; ++j)
#pragma unroll
        for (int i = 0; i < 8; ++i) s += R.v[j][i];
    const float mean = wave_sum(s) * (1.f / DM); float s2 = 0.f;
#pragma unroll
    for (int j = 0; j < 4; ++j)
#pragma unroll
        for (int i = 0; i < 8; ++i) { R.v[j][i] -= mean; s2 += R.v[j][i] * R.v[j][i]; }
    const float rstd = 1.f / sqrtf(wave_sum(s2) * (1.f / DM) + LN_EPS);
    if (strow && lane == 0) { strow[0] = mean; strow[1] = rstd; }
#pragma unroll
    for (int j = 0; j < 4; ++j) { const int c = (lane + 64 * j) * 8; float x[8];
        const f32x4 g0 = *(const f32x4*)(g + c), g1 = *(const f32x4*)(g + c + 4), b0 = *(const f32x4*)(bta + c), b1 = *(const f32x4*)(bta + c + 4);
#pragma unroll
        for (int i = 0; i < 4; ++i) { x[i] = R.v[j][i] * rstd * g0[i] + b0[i]; x[4 + i] = R.v[j][4 + i] * rstd * g1[i] + b1[i]; }
        if (xf) { *(f32x4*)(xf + c) = (f32x4){x[0], x[1], x[2], x[3]}; *(f32x4*)(xf + c + 4) = (f32x4){x[4], x[5], x[6], x[7]}; }
        if (hrow) { const f32x4 s0 = *(const f32x4*)(scale + c), s1 = *(const f32x4*)(scale + c + 4), h0 = *(const f32x4*)(shift + c), h1 = *(const f32x4*)(shift + c + 4); float h[8];
#pragma unroll
            for (int i = 0; i < 4; ++i) { h[i] = x[i] * (s0[i] + 1.0f) + h0[i]; h[4 + i] = x[4 + i] * (s1[i] + 1.0f) + h1[i]; }
            v4u o; o.x = pk2(h[0], h[1]); o.y = pk2(h[2], h[3]); o.z = pk2(h[4], h[5]); o.w = pk2(h[6], h[7]); *(v4u*)(hrow + c) = o; } }
}

__device__ __forceinline__ void ln_row_finish_pc(LnRowRegs& R, float* strow  , float* xf, bf16* hrow, const f32x4 (&Gp)[4][2], const f32x4 (&Bp)[4][2], int lane) {
    float s = 0.f;
#pragma unroll
    for (int j = 0; j < 4; ++j)
#pragma unroll
        for (int i = 0; i < 8; ++i) s += R.v[j][i];
    const float mean = wave_sum(s) * (1.f / DM); float s2 = 0.f;
#pragma unroll
    for (int j = 0; j < 4; ++j)
#pragma unroll
        for (int i = 0; i < 8; ++i) { R.v[j][i] -= mean; s2 += R.v[j][i] * R.v[j][i]; }
    const float rstd = 1.f / sqrtf(wave_sum(s2) * (1.f / DM) + LN_EPS);
    if (strow && lane == 0) { strow[0] = mean; strow[1] = rstd; }
#pragma unroll
    for (int j = 0; j < 4; ++j) { const int c = (lane + 64 * j) * 8; float x[8];
#pragma unroll
        for (int i = 0; i < 4; ++i) { x[i] = R.v[j][i] * rstd * Gp[j][0][i] + Bp[j][0][i]; x[4 + i] = R.v[j][4 + i] * rstd * Gp[j][1][i] + Bp[j][1][i]; }
        if (xf) { *(f32x4*)(xf + c) = (f32x4){x[0], x[1], x[2], x[3]}; *(f32x4*)(xf + c + 4) = (f32x4){x[4], x[5], x[6], x[7]}; }
        if (hrow) { v4u o; o.x = pk2(x[0], x[1]); o.y = pk2(x[2], x[3]); o.z = pk2(x[4], x[5]); o.w = pk2(x[6], x[7]); *(v4u*)(hrow + c) = o; } }
}

typedef short bf16x8 __attribute__((ext_vector_type(8)));
typedef float f32x16 __attribute__((ext_vector_type(16)));
#define MFMA16(a, b, c) __builtin_amdgcn_mfma_f32_16x16x32_bf16((a), (b), (c), 0, 0, 0)
#define MFMA32(a, b, c) __builtin_amdgcn_mfma_f32_32x32x16_bf16((a), (b), (c), 0, 0, 0)
__device__ __forceinline__ unsigned cvtpk(float lo, float hi) { unsigned r; asm volatile("v_cvt_pk_bf16_f32 %0, %1, %2" : "=v"(r) : "v"(lo), "v"(hi)); return r; }
__device__ __forceinline__ bf16x8 pack8(f32x4 a, f32x4 b) { v4u w; w.x = cvtpk(a[0], a[1]); w.y = cvtpk(a[2], a[3]); w.z = cvtpk(b[0], b[1]); w.w = cvtpk(b[2], b[3]); return __builtin_bit_cast(bf16x8, w); }
__device__ __forceinline__ int perm32i(int i) { return 8 * ((i >> 2) & 3) + 4 * (i >> 4) + (i & 3); }

constexpr int HG_T = 128, HG_NU = SEQ / HG_T  , HG_NU5 = HG_NU / 4  , HG_PITCH = 272  , HG_ARR = 128 * HG_PITCH;
constexpr float LOG2E = 1.4426950408889634f;

__device__ __forceinline__ void hg_gate(float z, float lb, float oml, float& k, float& lf2) {
    const float e = __builtin_amdgcn_exp2f(-LOG2E * fmaxf(z, -80.f)), s = __builtin_amdgcn_rcpf(1.f + e);
    k = oml * (e * s); lf2 = __builtin_amdgcn_logf(fmaxf(lb + oml * s, F_MIN));
}
__device__ __forceinline__ void hg_write_row32(LAS unsigned char* rowp  , const float (&v)[32]) {
#pragma unroll
    for (int g = 0; g < 4; ++g) { v4u w; w.x = cvtpk(v[4 * g], v[4 * g + 1]); w.y = cvtpk(v[4 * g + 2], v[4 * g + 3]); w.z = cvtpk(v[16 + 4 * g], v[16 + 4 * g + 1]); w.w = cvtpk(v[16 + 4 * g + 2], v[16 + 4 * g + 3]);
        *(LAS v4u*)(rowp + g * 16) = w; }
}

__device__ __forceinline__ int lane_id_local() { int l; asm volatile("v_mbcnt_lo_u32_b32 %0, -1, 0\n\tv_mbcnt_hi_u32_b32 %0, -1, %0" : "=v"(l)); return l; }
struct HgIn { unsigned z[16], q[16], v[16]; };
__device__ __forceinline__ void hg_load(HgIn& I, int unit, const bf16* Q, const unsigned short* Z, const bf16* VV, int wave, int lane, bool with_q) {
    const int bh = unit >> 5, sc = unit & 31, b = bh >> 3, h = bh & 7, c = wave >> 1, col = h * HD + 64 * (wave & 1) + lane;
    const size_t off = ((size_t)b * SEQ + sc * HG_T + 32 * c) * HW + col;
    Z += (size_t)b * (Z_BADD / 2);
#pragma unroll
    for (int s = 0; s < 16; ++s) { I.z[s] = (unsigned)Z[off + (size_t)(2 * s) * HW] | ((unsigned)Z[off + (size_t)(2 * s + 1) * HW] << 16);
        I.v[s] = (unsigned)VV[off + (size_t)(2 * s) * HW] | ((unsigned)VV[off + (size_t)(2 * s + 1) * HW] << 16);
        if (with_q) I.q[s] = (unsigned)Q[off + (size_t)(2 * s) * HW] | ((unsigned)Q[off + (size_t)(2 * s + 1) * HW] << 16); }
}
__device__ __forceinline__ unsigned short hg_get(const unsigned (&a)[16], int s) { return (unsigned short)((s & 1) ? (a[s >> 1] >> 16) : (a[s >> 1] & 0xffffu)); }
struct HgW { v4u z[4], q[4], v[4]; };
__device__ __forceinline__ void hg_loadw(HgW& W, int unit, const bf16* Q, const unsigned short* Z, const bf16* VV, int wave, int lane, bool with_q) {
    const int bh = unit >> 5, sc = unit & 31, b = bh >> 3, h = bh & 7, tid = wave * 64 + lane;
    Z += (size_t)b * (Z_BADD / 2);
    const size_t base = ((size_t)b * SEQ + sc * HG_T) * HW + h * HD;
#pragma unroll
    for (int k = 0; k < 4; ++k) { const int p = tid + 512 * k; const size_t o = base + (size_t)(p >> 4) * HW + (p & 15) * 8;
        W.z[k] = *(const v4u*)(Z + o); W.v[k] = *(const v4u*)(VV + o); if (with_q) W.q[k] = *(const v4u*)(Q + o); }
}
template <bool BAR2> __device__ __forceinline__ void hg_unstage(HgIn& I, const HgW& W, LAS unsigned char* lds, int wave, int lane, bool with_q) {
    const int tid = wave * 64 + lane;
#pragma unroll
    for (int k = 0; k < 4; ++k) { const int p = tid + 512 * k, o = (p >> 4) * HG_PITCH + (p & 15) * 16;
        *(LAS v4u*)(lds + o) = W.z[k]; *(LAS v4u*)(lds + HG_ARR + o) = W.v[k]; if (with_q) *(LAS v4u*)(lds + 2 * HG_ARR + o) = W.q[k]; }
    LDS_WAIT(); __syncthreads();
    const int c = wave >> 1, d = 64 * (wave & 1) + lane;
#pragma unroll
    for (int s = 0; s < 16; ++s) { const int o0 = (32 * c + 2 * s) * HG_PITCH + d * 2, o1 = o0 + HG_PITCH;
        I.z[s] = (unsigned)*(const LAS unsigned short*)(lds + o0) | ((unsigned)*(const LAS unsigned short*)(lds + o1) << 16);
        I.v[s] = (unsigned)*(const LAS unsigned short*)(lds + HG_ARR + o0) | ((unsigned)*(const LAS unsigned short*)(lds + HG_ARR + o1) << 16);
        if (with_q) I.q[s] = (unsigned)*(const LAS unsigned short*)(lds + 2 * HG_ARR + o0) | ((unsigned)*(const LAS unsigned short*)(lds + 2 * HG_ARR + o1) << 16); }
    if (BAR2) { LDS_WAIT(); __syncthreads(); }
}
__device__ __forceinline__ void hgrnA_unit(HgW& W, int nxt, int unit, const unsigned short* Z, const bf16* VV, const float* lbl, int l, f32x4 (&SA)[8], float& gsum, bool last_sub, int unit5, float* SLOC, float* GTOT, LAS unsigned char* lds, int wave, int lane_) {
    const int lane = lane_id_local();
    const int bh = unit >> 5, sc = unit & 31, b = bh >> 3, h = bh & 7;
    const int c = wave >> 1, d = 64 * (wave & 1) + lane, col = h * HD + d;
    const float lb = lower_bound_of(lbl, l, col), oml = 1.f - lb;
    HgIn I; hg_unstage<false>(I, W, lds + 2 * HG_ARR + 4096, wave, lane, false);
    const size_t row0 = (size_t)b * SEQ + sc * HG_T;
    LAS unsigned char* KT = lds; LAS unsigned char* VT = lds + HG_ARR; LAS float* TOT = (LAS float*)(lds + 2 * HG_ARR); LAS float* GS = TOT + 512;
    float cs[32], kk[32]; float run = 0.f;
    {
#pragma unroll
      for (int s = 0; s < 32; ++s) { float lf2; hg_gate((float)__builtin_bit_cast(_Float16, hg_get(I.z, s)), lb, oml, kk[s], lf2); run += lf2; cs[s] = run; } }
    TOT[c * 128 + d] = run;
    { float vv[32];
#pragma unroll
      for (int s = 0; s < 32; ++s) vv[s] = bf2f(hg_get(I.v, s));
      hg_write_row32(VT + d * HG_PITCH + 64 * c, vv); }
    if (nxt >= 0) hg_loadw(W, nxt, nullptr, Z, VV, wave, lane, false);
    LDS_WAIT(); __syncthreads();
    float suf = 0.f, tot = 0.f;
#pragma unroll
    for (int cc = 0; cc < 4; ++cc) { const float t = TOT[cc * 128 + d]; tot += t; if (cc > c) suf += t; }
#pragma unroll
    for (int s = 0; s < 32; ++s) kk[s] *= __builtin_amdgcn_exp2f(suf + run - cs[s]);
    hg_write_row32(KT + d * HG_PITCH + 64 * c, kk);
    if (c == 0) GS[d] = __builtin_amdgcn_exp2f(tot);
    gsum += tot;
    LDS_WAIT(); __syncthreads();
    const int g = lane >> 4, li = lane & 15;
    f32x4 acc[8];
#pragma unroll
    for (int a = 0; a < 8; ++a) acc[a] = (f32x4){0.f, 0.f, 0.f, 0.f};
#pragma unroll
    for (int ks = 0; ks < 4; ++ks) { const bf16x8 bfr = *(const LAS bf16x8*)(VT + (16 * wave + li) * HG_PITCH + (32 * ks + 8 * g) * 2);
#pragma unroll
        for (int a = 0; a < 8; ++a) { const bf16x8 afr = *(const LAS bf16x8*)(KT + (16 * a + li) * HG_PITCH + (32 * ks + 8 * g) * 2); acc[a] = MFMA16(afr, bfr, acc[a]); } }
#pragma unroll
    for (int a = 0; a < 8; ++a) { const f32x4 gv = *(const LAS f32x4*)(GS + 16 * a + 4 * g); SA[a] = SA[a] * gv + acc[a]; }
    if (last_sub) { float* so = SLOC + (size_t)unit5 * 16384 + (size_t)(unit5 >> 6) * (SL_BADD / 4) + (size_t)wave * 2048 + 4 * lane;
#pragma unroll
        for (int a = 0; a < 8; ++a) *(f32x4*)(so + a * 256) = SA[a];
        if (c == 0) GTOT[(size_t)unit5 * 128 + d] = __builtin_amdgcn_exp2f(gsum); }
    LDS_WAIT(); __syncthreads();
}
__device__ __forceinline__ void hgrnC_unit(HgW& W, int nxt, int unit, const bf16* Q, const unsigned short* Z, const bf16* VV, const bf16* SG, const float* ng  , const float* lbl, int l, f32x4 (&S)[8]  , bf16* HO, LAS unsigned char* lds, int wave, int lane_) {
    const int lane = lane_id_local();
    const int bh = unit >> 5, sc = unit & 31, b = bh >> 3, h = bh & 7;
    const float lb = lower_bound_of(lbl, l, h * HD + 64 * (wave & 1) + lane), oml = 1.f - lb;
    HgIn I; hg_unstage<true>(I, W, lds, wave, lane, true);
    const size_t row0 = (size_t)b * SEQ + sc * HG_T;
    LAS unsigned char* QT = lds; LAS unsigned char* KTt = lds + HG_ARR; LAS unsigned char* KPT = lds + 2 * HG_ARR; LAS unsigned char* VT = lds + 3 * HG_ARR;
    LAS float* GB = (LAS float*)(lds + 4 * HG_ARR); LAS float* RED = (LAS float*)(lds + 4 * HG_ARR + 2048);
    { const int c = wave >> 1, d = 64 * (wave & 1) + lane, pd = (d & ~31) + perm32i(d & 31);
      float bs[32], kk[32]; float run = 0.f;
#pragma unroll
      for (int s = 0; s < 32; ++s) { float lf2; hg_gate((float)__builtin_bit_cast(_Float16, hg_get(I.z, s)), lb, oml, kk[s], lf2); run += lf2; bs[s] = run; }
      GB[c * 128 + d] = __builtin_amdgcn_exp2f(run);
#pragma unroll
      for (int s = 0; s < 32; ++s) { const float qv = bf2f(hg_get(I.q, s));
          *(LAS unsigned short*)(QT + (32 * c + s) * HG_PITCH + pd * 2) = (unsigned short)f2bf(qv * __builtin_amdgcn_exp2f(bs[s]));
          *(LAS unsigned short*)(KTt + (32 * c + s) * HG_PITCH + pd * 2) = (unsigned short)f2bf(kk[s] * __builtin_amdgcn_exp2f(-bs[s])); }
#pragma unroll
      for (int s = 0; s < 32; ++s) kk[s] *= __builtin_amdgcn_exp2f(run - bs[s]);
      hg_write_row32(KPT + d * HG_PITCH + 64 * c, kk);
      float vv[32];
#pragma unroll
      for (int s = 0; s < 32; ++s) vv[s] = bf2f(hg_get(I.v, s));
      hg_write_row32(VT + d * HG_PITCH + 64 * c, vv); }
    if (nxt >= 0) hg_loadw(W, nxt, Q, Z, VV, wave, lane, true);
    LDS_WAIT(); __syncthreads();
    const int g = lane >> 4, li = lane & 15;
    f32x4 oT[4][2];
    v2u sgv[4][2];
#pragma unroll
    for (int c = 0; c < 4; ++c)
#pragma unroll
        for (int ti = 0; ti < 2; ++ti) sgv[c][ti] = *(const v2u*)(SG + (row0 + 32 * c + 16 * ti + li) * HW + h * HD + 16 * wave + 4 * g);
    const f32x4 ngv = *(const f32x4*)(ng + h * HD + 16 * wave + 4 * g);
#pragma unroll
    for (int c = 0; c < 4; ++c) {
        bf16x8 qf[2][4];
#pragma unroll
        for (int ti = 0; ti < 2; ++ti)
#pragma unroll
            for (int ks = 0; ks < 4; ++ks) qf[ti][ks] = *(const LAS bf16x8*)(QT + (32 * c + 16 * ti + li) * HG_PITCH + (32 * ks + 8 * g) * 2);
        f32x4 PT[2][2];
#pragma unroll
        for (int si = 0; si < 2; ++si)
#pragma unroll
            for (int ti = 0; ti < 2; ++ti) PT[si][ti] = (f32x4){0.f, 0.f, 0.f, 0.f};
#pragma unroll
        for (int ks = 0; ks < 4; ++ks)
#pragma unroll
            for (int si = 0; si < 2; ++si) { const bf16x8 kf = *(const LAS bf16x8*)(KTt + (32 * c + 16 * si + li) * HG_PITCH + (32 * ks + 8 * g) * 2);
#pragma unroll
                for (int ti = 0; ti < 2; ++ti) PT[si][ti] = MFMA16(kf, qf[ti][ks], PT[si][ti]); }
#pragma unroll
        for (int si = 0; si < 2; ++si)
#pragma unroll
            for (int ti = 0; ti < 2; ++ti)
#pragma unroll
                for (int r = 0; r < 4; ++r) if (16 * si + 4 * g + r > 16 * ti + li) PT[si][ti][r] = 0.f;
        const bf16x8 vf = *(const LAS bf16x8*)(VT + (16 * wave + li) * HG_PITCH + (32 * c + 8 * g) * 2);
#pragma unroll
        for (int ti = 0; ti < 2; ++ti) {
            f32x4 o = MFMA16(vf, pack8(PT[0][ti], PT[1][ti]), ((f32x4){0.f, 0.f, 0.f, 0.f}));
#pragma unroll
            for (int ks = 0; ks < 4; ++ks) o = MFMA16(pack8(S[2 * ks], S[2 * ks + 1]), qf[ti][ks], o);
            oT[c][ti] = o; }
#pragma unroll
        for (int a = 0; a < 8; ++a) { const f32x4 gv = *(const LAS f32x4*)(GB + c * 128 + 16 * a + 4 * g); S[a] = S[a] * gv;
            const bf16x8 kf = *(const LAS bf16x8*)(KPT + (16 * a + li) * HG_PITCH + (32 * c + 8 * g) * 2); S[a] = MFMA16(kf, vf, S[a]); }
    }
#pragma unroll
    for (int c = 0; c < 4; ++c)
#pragma unroll
        for (int ti = 0; ti < 2; ++ti) { const f32x4 o = oT[c][ti]; float p = (o[0] * o[0] + o[1] * o[1]) + (o[2] * o[2] + o[3] * o[3]); p += __shfl_xor(p, 16); p += __shfl_xor(p, 32);
            if (g == 0) RED[wave * 128 + 32 * c + 16 * ti + li] = p; }
    LDS_WAIT(); __syncthreads();
#pragma unroll
    for (int c = 0; c < 4; ++c)
#pragma unroll
        for (int ti = 0; ti < 2; ++ti) { const int t = 32 * c + 16 * ti + li; float tot = 0.f;
#pragma unroll
            for (int w = 0; w < 8; ++w) tot += RED[w * 128 + t];
            const float rinv = 1.f / sqrtf(tot * (1.f / HD) + RMS_EPS);
            const size_t offo = (row0 + t) * (size_t)(2 * HW) + h * HD + 16 * wave + 4 * g;
            const v2u sg = sgv[c][ti]; const f32x4 o = oT[c][ti];
            v2u w; w.x = pk2(o[0] * rinv * ngv[0] * __uint_as_float(sg.x << 16), o[1] * rinv * ngv[1] * __uint_as_float(sg.x & 0xffff0000u));
            w.y = pk2(o[2] * rinv * ngv[2] * __uint_as_float(sg.y << 16), o[3] * rinv * ngv[3] * __uint_as_float(sg.y & 0xffff0000u));
            *(v2u*)(HO + offo) = w; }
    LDS_WAIT(); __syncthreads();
}

__device__ __forceinline__ void kmean_wg(int it, const bf16* MK, float* KMEAN, LAS float* red, int wave, int lane) {
    const int sub = it * 2 + (wave >> 2), qr = wave & 3, h = sub & 7, n = (sub >> 3) & 15, b = sub >> 7;
    const bf16* p = MK + ((size_t)b * SEQ + n * MB_BLOCK + qr * 64) * HW + h * HD + 2 * lane;
    float s0 = 0.f, s1 = 0.f;
#pragma unroll
    for (int j = 0; j < 64; ++j) { const unsigned w = *(const unsigned*)(p + (size_t)j * HW); s0 += __uint_as_float(w << 16); s1 += __uint_as_float(w & 0xffff0000u); }
    red[wave * 128 + 2 * lane] = s0; red[wave * 128 + 2 * lane + 1] = s1;
    LDS_WAIT(); __syncthreads();
    if (qr == 0) { const int w0 = wave; float a0 = 0.f, a1 = 0.f;
#pragma unroll
        for (int q = 0; q < 4; ++q) { a0 += red[(w0 + q) * 128 + 2 * lane]; a1 += red[(w0 + q) * 128 + 2 * lane + 1]; }
        float* o = KMEAN + (((size_t)(b * NH + h) * MB_NB + n) * HD + 2 * lane); o[0] = a0 * (1.f / MB_BLOCK); o[1] = a1 * (1.f / MB_BLOCK); }
    LDS_WAIT(); __syncthreads();
}
__device__ __forceinline__ void mvt_load(int it, const bf16* MV, v4u (&w)[8], int lane) {
    const int dh = it & 1, tg = (it >> 1) & 63, h = (it >> 7) & 7, b = it >> 10;
    const bf16* src = MV + ((size_t)b * SEQ + tg * 64 + lane) * HW + h * HD + 64 * dh;
#pragma unroll
    for (int c = 0; c < 8; ++c) w[c] = *(const v4u*)(src + 8 * c);
}
__device__ __forceinline__ void mvt_finish(int it, const v4u (&wv)[8], bf16* MVT, LAS unsigned short* tile  , int lane) {
    const int dh = it & 1, tg = (it >> 1) & 63, h = (it >> 7) & 7, b = it >> 10;
    const int i16 = lane & 15, pos = (lane & ~15) + 8 * ((i16 >> 2) & 1) + 4 * (i16 >> 3) + (i16 & 3);
#pragma unroll
    for (int c = 0; c < 8; ++c) { const v4u w = wv[c]; const unsigned ww[4] = {w.x, w.y, w.z, w.w};
#pragma unroll
        for (int j = 0; j < 4; ++j) { tile[(8 * c + 2 * j) * 72 + pos] = (unsigned short)(ww[j] & 0xffffu); tile[(8 * c + 2 * j + 1) * 72 + pos] = (unsigned short)(ww[j] >> 16); } }
    LDS_WAIT(); asm volatile("" ::: "memory");
    bf16* dst = MVT + ((size_t)(b * NH + h) * HD + 64 * dh) * SEQ + (size_t)b * (MVT_BADD / 2) + tg * 64;
#pragma unroll
    for (int j = 0; j < 8; ++j) { const int dd = (lane >> 3) + 8 * j, part = lane & 7; const v4u w = *(const LAS v4u*)(tile + dd * 72 + part * 8); *(v4u*)(dst + (size_t)dd * SEQ + part * 8) = w; }
    LDS_WAIT(); asm volatile("" ::: "memory");
}
__device__ __forceinline__ void sel_item(int idx, const bf16* MQ, const float* KMEAN, unsigned* SEL) {
    const int t = idx & (SEQ - 1), bh = idx >> 12, b = bh >> 3, h = bh & 7, qb = t >> 8;
    const size_t row = (size_t)b * SEQ + t;
    unsigned mask = 0u;
    if (qb > 0) {
        float q[HD];
        const bf16* qp = MQ + row * HW + h * HD;
#pragma unroll
        for (int c = 0; c < 16; ++c) { const v4u w = *(const v4u*)(qp + c * 8);
            q[c * 8 + 0] = __uint_as_float(w.x << 16); q[c * 8 + 1] = __uint_as_float(w.x & 0xffff0000u); q[c * 8 + 2] = __uint_as_float(w.y << 16); q[c * 8 + 3] = __uint_as_float(w.y & 0xffff0000u);
            q[c * 8 + 4] = __uint_as_float(w.z << 16); q[c * 8 + 5] = __uint_as_float(w.z & 0xffff0000u); q[c * 8 + 6] = __uint_as_float(w.w << 16); q[c * 8 + 7] = __uint_as_float(w.w & 0xffff0000u); }
        const float* km = KMEAN + (size_t)(b * NH + h) * MB_NB * HD;
        float g0 = -INFINITY, g1 = -INFINITY, g2 = -INFINITY; int i0 = -1, i1 = -1, i2 = -1;
        for (int n = 0; n < qb; ++n) {
            float s = 0.f;
#pragma unroll
            for (int d = 0; d < HD; ++d) s += q[d] * km[n * HD + d];
            if (s > g0) { g2 = g1; i2 = i1; g1 = g0; i1 = i0; g0 = s; i0 = n; }
            else if (s > g1) { g2 = g1; i2 = i1; g1 = s; i1 = n; }
            else if (s > g2) { g2 = s; i2 = n; }
        }
        if (i0 >= 0) mask |= 1u << i0; if (i1 >= 0) mask |= 1u << i1; if (i2 >= 0) mask |= 1u << i2;
    }
    SEL[row * NH + h] = mask;
}
constexpr int MB_KB = 64 * 272, MB_VB = 128 * 144;
__device__ __forceinline__ void moba_unit(int bh, int qb, bool desc, const bf16* MQ, const bf16* MK, const bf16* MVT, const float* KMEAN, bf16* MO, LAS unsigned char* lds, int wave, int lane) {
    const int b = bh >> 3, h = bh & 7, tid = wave * 64 + lane, ql = lane & 31, hh = lane >> 5;
    const size_t rowq = (size_t)b * SEQ + qb * MB_BLOCK + wave * 32 + ql;
    bf16x8 qf[8];
#pragma unroll
    for (int ks = 0; ks < 8; ++ks) qf[ks] = *(const bf16x8*)(MQ + rowq * HW + h * HD + 16 * ks + 8 * hh);
    LAS unsigned char* KB = lds; LAS unsigned char* VB = lds + 2 * MB_KB;
    const bf16* kbase = MK + (size_t)b * SEQ * HW + h * HD; const bf16* vbase = MVT + (size_t)(b * NH + h) * HD * SEQ + (size_t)b * (MVT_BADD / 2);
    v4u kreg[2], vreg[2];
#define MB_PAST(i) (desc ? qb - 1 - (((i) - 4) >> 2) : (((i) - 4) >> 2))
#define MB_LOAD(i) do { const int blk_ = ((i) < 4) ? qb : MB_PAST(i); const int key0_ = blk_ * MB_BLOCK + ((i) & 3) * 64; \
        _Pragma("unroll") for (int j_ = 0; j_ < 2; ++j_) { const int id_ = tid + 512 * j_; kreg[j_] = *(const v4u*)(kbase + (size_t)(key0_ + (id_ >> 4)) * HW + (id_ & 15) * 8); \
            vreg[j_] = *(const v4u*)(vbase + (size_t)(id_ >> 3) * SEQ + key0_ + (id_ & 7) * 8); } } while (0)
#define MB_STORE(buf) do { _Pragma("unroll") for (int j_ = 0; j_ < 2; ++j_) { const int id_ = tid + 512 * j_; *(LAS v4u*)(KB + (buf) * MB_KB + (id_ >> 4) * 272 + (id_ & 15) * 16) = kreg[j_]; \
            *(LAS v4u*)(VB + (buf) * MB_VB + (id_ >> 3) * 144 + (id_ & 7) * 16) = vreg[j_]; } } while (0)
    MB_LOAD(0);
    unsigned sel = 0u;
    if (qb > 0) {
        LAS float* KM = (LAS float*)(lds + 73728);
        const float* kmg = KMEAN + (size_t)bh * MB_NB * HD;
        for (int i = tid; i < qb * 32; i += 512) *(LAS f32x4*)(KM + i * 4) = *(const f32x4*)(kmg + i * 4);
        LDS_WAIT(); __syncthreads();
        float g0 = -INFINITY, g1 = -INFINITY, g2 = -INFINITY; int i0 = -1, i1 = -1, i2 = -1;
        for (int n = 0; n < qb; ++n) { float sc_ = 0.f;
#pragma unroll
            for (int ks = 0; ks < 8; ++ks) { const f32x4 ka = *(const LAS f32x4*)(KM + n * HD + 16 * ks + 8 * hh), kb = *(const LAS f32x4*)(KM + n * HD + 16 * ks + 8 * hh + 4);
                const v4u w = __builtin_bit_cast(v4u, qf[ks]);
                sc_ += __uint_as_float(w.x << 16) * ka.x + __uint_as_float(w.x & 0xffff0000u) * ka.y + __uint_as_float(w.y << 16) * ka.z + __uint_as_float(w.y & 0xffff0000u) * ka.w
                     + __uint_as_float(w.z << 16) * kb.x + __uint_as_float(w.z & 0xffff0000u) * kb.y + __uint_as_float(w.w << 16) * kb.z + __uint_as_float(w.w & 0xffff0000u) * kb.w; }
            sc_ += __shfl_xor(sc_, 32);
            if (sc_ > g0) { g2 = g1; i2 = i1; g1 = g0; i1 = i0; g0 = sc_; i0 = n; }
            else if (sc_ > g1) { g2 = g1; i2 = i1; g1 = sc_; i1 = n; }
            else if (sc_ > g2) { g2 = sc_; i2 = n; } }
        if (i0 >= 0) sel |= 1u << i0; if (i1 >= 0) sel |= 1u << i1; if (i2 >= 0) sel |= 1u << i2;
    }
    f32x16 O[4];
#pragma unroll
    for (int dt = 0; dt < 4; ++dt)
#pragma unroll
        for (int r = 0; r < 16; ++r) O[dt][r] = 0.f;
    float m_used = 0.f, lsum = 0.f;
    const int nt = 4 * (qb + 1);
    MB_STORE(0); LDS_WAIT(); __syncthreads();
    for (int i = 0; i < nt; ++i) {
        if (i + 1 < nt) MB_LOAD(i + 1);
        const LAS unsigned char* Kc = KB + (i & 1) * MB_KB; const LAS unsigned char* Vc = VB + (i & 1) * MB_VB;
#pragma unroll
        for (int mt = 0; mt < 2; ++mt) {
            if (i < 4 && (i & 3) * 64 + 32 * mt > wave * 32 + 31) continue;
            f32x16 sT;
            { const float c0 = (i < 4 || ((sel >> MB_PAST(i)) & 1u)) ? -m_used : -INFINITY;
#pragma unroll
              for (int r = 0; r < 16; ++r) sT[r] = c0; }
#pragma unroll
            for (int ks = 0; ks < 8; ++ks) { const bf16x8 kf = *(const LAS bf16x8*)(Kc + (32 * mt + ql) * 272 + (16 * ks + 8 * hh) * 2); sT = MFMA32(kf, qf[ks], sT); if ((ks & 3) == 3) asm volatile("" ::: "memory"); }
            if (i < 4) { const int qi = wave * 32 + ql - (i & 3) * 64;
#pragma unroll
                for (int r = 0; r < 16; ++r) if (32 * mt + (r & 3) + 8 * (r >> 2) + 4 * hh > qi) sT[r] = -INFINITY; }
            float rm = sT[0];
#pragma unroll
            for (int r = 1; r < 16; ++r) rm = fmaxf(rm, sT[r]);
            rm = fmaxf(rm, __shfl_xor(rm, 32));
            const bool first = (i == 0 && mt == 0);
            if (first || __any(rm > 8.f)) {
                const float dl = first ? rm : fmaxf(rm, 0.f), al = __builtin_amdgcn_exp2f(-dl); m_used += dl; lsum *= al;
#pragma unroll
                for (int r = 0; r < 16; ++r) sT[r] -= dl;
#pragma unroll
                for (int dt = 0; dt < 4; ++dt)
#pragma unroll
                    for (int r = 0; r < 16; ++r) O[dt][r] *= al; }
#pragma unroll
            for (int r = 0; r < 16; ++r) { const float pe = __builtin_amdgcn_exp2f(sT[r]); sT[r] = pe; lsum += pe; }
            bf16x8 pf[2];
#pragma unroll
            for (int s2 = 0; s2 < 2; ++s2) { v4u w; w.x = cvtpk(sT[8 * s2], sT[8 * s2 + 1]); w.y = cvtpk(sT[8 * s2 + 2], sT[8 * s2 + 3]); w.z = cvtpk(sT[8 * s2 + 4], sT[8 * s2 + 5]); w.w = cvtpk(sT[8 * s2 + 6], sT[8 * s2 + 7]);
                pf[s2] = __builtin_bit_cast(bf16x8, w); }
#pragma unroll
            for (int dt = 0; dt < 4; ++dt) {
#pragma unroll
                for (int s2 = 0; s2 < 2; ++s2) { const bf16x8 vf = *(const LAS bf16x8*)(Vc + (32 * dt + ql) * 144 + (16 * (2 * mt + s2) + 8 * hh) * 2); O[dt] = MFMA32(vf, pf[s2], O[dt]); }
                if (dt & 1) asm volatile("" ::: "memory"); }
        }
        if (i + 1 < nt) MB_STORE((i + 1) & 1);
        LDS_WAIT(); __syncthreads();
    }
#undef MB_LOAD
#undef MB_STORE
#undef MB_PAST
    const float inv = 1.f / (lsum + __shfl_xor(lsum, 32));
    bf16* op = MO + rowq * (size_t)(2 * HW) + h * HD + 4 * hh;
#pragma unroll
    for (int dt = 0; dt < 4; ++dt)
#pragma unroll
        for (int rq = 0; rq < 4; ++rq) { v2u w; w.x = pk2(O[dt][4 * rq] * inv, O[dt][4 * rq + 1] * inv); w.y = pk2(O[dt][4 * rq + 2] * inv, O[dt][4 * rq + 3] * inv); *(v2u*)(op + 32 * dt + 8 * rq) = w; }
}
#ifndef REP_P0
#define REP_P0 1
#endif
#ifndef REP_LN
#define REP_LN 1
#endif
#ifndef REP_GEMM
#define REP_GEMM 1
#endif
#ifndef REP_A
#define REP_A 1
#endif
#ifndef REP_B
#define REP_B 1
#endif
#ifndef REP_MOBA
#define REP_MOBA 1
#endif
#ifndef REP_HC
#define REP_HC 1
#endif
struct Args { const float* in[15]; float* out; unsigned char* ws; int ph_lo, ph_hi; };
#ifndef MK_N_LAUNCHES
#define MK_N_LAUNCHES 1
#endif
constexpr int N_PHASES = 3 + DEPTH * (3 + 6 + 3);

constexpr int CW_CONV = 8192 + 512;
constexpr int CW_PBAR = 16384;
constexpr int CW_GRP = 8192;
struct Pipe { int pg, lw, gp; unsigned* cnt; unsigned* tmo; };
__device__ __forceinline__ Pipe make_pipe(unsigned* ctl) { Pipe P; const int G = gridDim.x, c = blockIdx.x;
    P.pg = (c & 7) >> 1; P.lw = (c >> 3) * 2 + (c & 1); P.gp = G >> 2;
    P.cnt = ctl + CW_GRP + 64 * P.pg; P.tmo = ctl + CW_BAR + XB_TMO; return P; }
__device__ __forceinline__ void grp_barrier(const Pipe& P, unsigned& epoch) {
    asm volatile("s_waitcnt vmcnt(0)" ::: "memory");
    __syncthreads();
    ++epoch;
    if (threadIdx.x == 0) {
        __builtin_amdgcn_fence(__ATOMIC_RELEASE, "agent");
        asm volatile("s_waitcnt vmcnt(0)" ::: "memory");
        (void)__hip_atomic_fetch_add(P.cnt, 1u, __ATOMIC_RELAXED, __HIP_MEMORY_SCOPE_AGENT);
        const unsigned target = epoch * (unsigned)P.gp; unsigned sp = 0;
        while (__hip_atomic_load(P.cnt, __ATOMIC_RELAXED, __HIP_MEMORY_SCOPE_AGENT) < target) { __builtin_amdgcn_s_sleep(1);
            if ((++sp & 255u) == 0u) { if (xb_ld(P.tmo)) break; if (sp > XB_SPIN_CAP) { atomicAdd(P.tmo, 1u); break; } } }
        __builtin_amdgcn_fence(__ATOMIC_ACQUIRE, "agent");
        asm volatile("s_waitcnt vmcnt(0)" ::: "memory");
    }
    __syncthreads();
}
#define ROWX(v) (((((v) >> 3) & 1) << 11) | ((((v) >> 4) << 3) | ((v) & 7)))
#define PH_RUN (lo <= ph && ph < hi)
#ifndef REP_BAR
#define REP_BAR 1
#endif
#define PIPE_HERE const Pipe PP = make_pipe((unsigned*)(args.ws + WS_CTL)); const int pgw = PP.lw * NWAVES + wave, PNGW = PP.gp * NWAVES
#define PH_END do { if (lo <= ph && ph + 1 < hi) { if (ph < 1) xcd_barrier(bar); else xcd_barrier(pbar); } ++ph; } while (0)
template <int l, int sub>
__device__ __forceinline__ void sub_layer(const Args& args, LAS unsigned char* lds, const XcdBarrier& bar, const XcdBarrier& pbar, int lo, int hi, int wave, int lane) {
    const int tid = threadIdx.x; const int G = gridDim.x, gw = blockIdx.x * NWAVES + wave, NGW = G * NWAVES, gt = blockIdx.x * (NWAVES * 64) + tid, NGT = G * NWAVES * 64;
    unsigned char* ws = args.ws; const float* x_in = args.in[0]; const float* ln_g = args.in[4]; const float* ln_b = args.in[5]; const float* lbl = args.in[10]; const float* hg_ng = args.in[11];
    float* STATS = (float*)(ws + WS_STATS); float* MOD = (float*)(ws + WS_MOD); unsigned short* V = (unsigned short*)(ws + WS_V); bf16* H = (bf16*)(ws + WS_H); unsigned char* R = ws + WS_R;
    unsigned char* OUTS = (unsigned char*)args.out;
    unsigned char* wl = ws + WS_WTS + (size_t)l * WL_STRIDE;
    int ph = 3 + l * 12 + (sub == 0 ? 0 : (sub == 1 ? 3 : 9));

            const float* gatev = MOD + (size_t)l * BATCH * NMOD + (sub * 3 + 2) * DM;
            if (sub != 1) {
                const int f = sub >> 1;
                if (PH_RUN) {
                    pg8::Gemm g{H, (const bf16*)(wl + WO_GU) + (size_t)f * NIN * DM, MTOK, NIN, DM}; pg8::RevOrder S; S.init(MTOK, NIN, G, (int)blockIdx.x);
                    pg8::EpiGateUp E{(bf16*)(R + R_ACT), FF};
#ifndef NO_G_GU
                    pg8::gemm_phase<pg8::EpiGateUp, pg8::RevOrder, true, true>(lds, g, S, E);
#endif
                }
                PH_END;
                if (PH_RUN) {
                    pg8::Gemm g{(const bf16*)(R + R_ACT), (const bf16*)(wl + WO_D) + (size_t)f * DM * FF, MTOK, DM, FF}; pg8::StaticOrder S; S.init(MTOK, DM, G, (int)blockIdx.x);
                    constexpr bool XF = (l == 0 && sub == 0); constexpr int pli = XF ? 0 : l * NSUB + sub - 1;
                    typedef pg8::EpiResid<XF, DM, NMOD, SEQ, 1> EpiR; EpiR E{x_in, V, gatev, STATS, ln_g + (size_t)pli * DM, ln_b + (size_t)pli * DM};
#ifndef NO_G_DN
                    pg8::gemm_phase<EpiR, pg8::StaticOrder, true, true>(lds, g, S, E);
#endif
                }
                PH_END;
            } else {
                if (PH_RUN) {
                    if (l == 0) {
                        if (tid == 0) { unsigned* cv = (unsigned*)(args.ws + WS_CTL) + CW_CONV; unsigned* tmo_ = (unsigned*)(args.ws + WS_CTL) + CW_BAR + XB_TMO; unsigned sp = 0;
                            while (__hip_atomic_load(cv, __ATOMIC_RELAXED, __HIP_MEMORY_SCOPE_AGENT) < (unsigned)G) { __builtin_amdgcn_s_sleep(1);
                                if ((++sp & 255u) == 0u) { if (xb_ld(tmo_)) break; if (sp > XB_SPIN_CAP) { atomicAdd(tmo_, 1u); break; } } }
                            __builtin_amdgcn_fence(__ATOMIC_ACQUIRE, "agent"); asm volatile("s_waitcnt vmcnt(0)" ::: "memory"); }
                        __syncthreads(); }
                    pg8::Gemm g{H, (const bf16*)(wl + WO_IN), MTOK, NIN, DM}; pg8::RevOrder S; S.init(MTOK, NIN, G, (int)blockIdx.x);
                    typedef pg8::EpiInProj<R_Q, R_VV, R_SG, R_MQ, R_MK, R_MV, R_GA, R_GB, Z_BADD> EpiIP; EpiIP E{R, OUTS + DO_Z};
#ifndef NO_G_IN
                    pg8::gemm_phase<EpiIP, pg8::RevOrder, true, true>(lds, g, S, E);
#endif
                }
                PH_END;
                if (PH_RUN) { _Pragma("unroll 1") for (int rep_ = 0; rep_ < REP_A; ++rep_) { if (rep_) { VM_WAIT(); __syncthreads(); }
                  PIPE_HERE;
                  { const int bb = PP.pg;
#ifndef NO_HA
                    HgW I; if (PP.lw < NH * HG_NU5) hg_loadw(I, (bb * (NH * HG_NU5) + PP.lw) * 4, nullptr, (const unsigned short*)(OUTS + DO_Z), (const bf16*)(R + R_VV), wave, lane_id_local(), false);
#endif
                    for (int it = PP.lw; it < 64; it += PP.gp) kmean_wg(bb * 64 + it, (const bf16*)(R + R_MK), (float*)(ws + WS_KMEAN), (LAS float*)lds, wave, lane);
                    for (int it = pgw; it < NH * 64 * 2; it += 2 * PNGW) {
                        v4u wA[8], wB[8]; const bool two = it + PNGW < NH * 64 * 2;
                        mvt_load(bb * (NH * 64 * 2) + it, (const bf16*)(R + R_MV), wA, lane); if (two) mvt_load(bb * (NH * 64 * 2) + it + PNGW, (const bf16*)(R + R_MV), wB, lane);
                        mvt_finish(bb * (NH * 64 * 2) + it, wA, (bf16*)(OUTS + DO_MVT), (LAS unsigned short*)(lds + wave * 9216), lane);
                        if (two) mvt_finish(bb * (NH * 64 * 2) + it + PNGW, wB, (bf16*)(OUTS + DO_MVT), (LAS unsigned short*)(lds + wave * 9216), lane); }
                    __syncthreads();
#ifndef NO_HA
                    { const int NUB = NH * HG_NU5  ; int il = PP.lw; const unsigned short* Zp = (const unsigned short*)(OUTS + DO_Z); const bf16* Vp = (const bf16*)(R + R_VV);
#pragma unroll 1
                      for (; il < NUB; il += PP.gp) { const int u5 = bb * NUB + il; f32x4 SA[8]; float gsum = 0.f;
#pragma unroll
                          for (int a_ = 0; a_ < 8; ++a_) SA[a_] = (f32x4){0.f, 0.f, 0.f, 0.f};
#pragma unroll 1
                          for (int j = 0; j < 4; ++j) { const int nxt = (j < 3) ? u5 * 4 + j + 1 : ((il + PP.gp < NUB) ? (u5 + PP.gp) * 4 : -1);
                              hgrnA_unit(I, nxt, u5 * 4 + j, Zp, Vp, lbl, l, SA, gsum, j == 3, u5, (float*)(OUTS + DO_SL), (float*)(ws + WS_GTOT), lds, wave, lane); } } }
                  }
#endif
                } }
                PH_END;
                if (PH_RUN) {
                  PIPE_HERE;
                  { const int bb = PP.pg;
                    for (int pl = PP.lw; pl < NH * 8; pl += PP.gp) { const int bh = bb * NH + (pl & 1) * 4 + (pl >> 4), s = (pl >> 1) & 7;
#ifndef NO_MOBA2
#pragma unroll 1
                        for (int j = 0; j < 2 * REP_MOBA; ++j) moba_unit(bh, (j & 1) ? s : 15 - s, (j & 1) != 0, (const bf16*)(R + R_MQ), (const bf16*)(R + R_MK), (const bf16*)(OUTS + DO_MVT), (const float*)(ws + WS_KMEAN), (bf16*)(R + R_SLOC) + HW, lds, wave, lane);
#endif
                    }
#ifndef NO_HC
                    { HgW I; const int NUB = NH * HG_NU5; int il = PP.lw; const bf16* Qp = (const bf16*)(R + R_Q); const unsigned short* Zp = (const unsigned short*)(OUTS + DO_Z); const bf16* Vp = (const bf16*)(R + R_VV);
                      const float* SL5 = (const float*)(OUTS + DO_SL); const float* GT5 = (const float*)(ws + WS_GTOT);
                      if (il < NUB) hg_loadw(I, (bb * NUB + il) * 4, Qp, Zp, Vp, wave, lane, true);
#pragma unroll 1
                      for (; il < NUB; il += PP.gp) { const int u5 = bb * NUB + il, bh5 = u5 >> 3, seg = u5 & 7, g_ = lane >> 4;
                          f32x4 S[8];
#pragma unroll
                          for (int a_ = 0; a_ < 8; ++a_) S[a_] = (f32x4){0.f, 0.f, 0.f, 0.f};
#pragma unroll 1
                          for (int jj = 0; jj < seg; ++jj) { const float* sp = SL5 + (size_t)(bh5 * 8 + jj) * 16384 + (size_t)(bh5 >> 3) * (SL_BADD / 4) + (size_t)wave * 2048 + 4 * lane; const float* gp = GT5 + (size_t)(bh5 * 8 + jj) * 128 + 4 * g_;
#pragma unroll
                              for (int a_ = 0; a_ < 8; ++a_) { const f32x4 gv = *(const f32x4*)(gp + 16 * a_); const f32x4 t_ = *(const f32x4*)(sp + a_ * 256);
                                  S[a_] = S[a_] * gv + t_; } }
#pragma unroll 1
                          for (int j = 0; j < 4; ++j) { const int nxt = (j < 3) ? u5 * 4 + j + 1 : ((il + PP.gp < NUB) ? (u5 + PP.gp) * 4 : -1);
                              hgrnC_unit(I, nxt, u5 * 4 + j, Qp, Zp, Vp, (const bf16*)(R + R_SG), hg_ng + l * HW, lbl, l, S, (bf16*)(R + R_SLOC), lds, wave, lane); } } }
#endif
                }
                PH_END;
                if (PH_RUN) {
                    { pg8::Gemm g{(const bf16*)(R + R_SLOC), (const bf16*)(wl + WO_A), MTOK, DM, 2 * HW}; pg8::StaticOrder S; S.init(MTOK, DM, G, (int)blockIdx.x);
                      pg8::EpiMerge E{(const bf16*)(R + R_GA), (const bf16*)(R + R_GB), (bf16*)(R + R_Z), DM};
                      pg8::gemm_phase<pg8::EpiMerge, pg8::StaticOrder, true, true>(lds, g, S, E);
                    }
                }
                PH_END;
                if (PH_RUN) {
                    pg8::Gemm g{(const bf16*)(R + R_Z), (const bf16*)(wl + WO_O), MTOK, DM, DM}; pg8::StaticOrder S; S.init(MTOK, DM, G, (int)blockIdx.x);
                    constexpr int pli = l * NSUB + sub - 1; typedef pg8::EpiResid<false, DM, NMOD, SEQ, 0> EpiR; EpiR E{x_in, V, gatev, STATS, ln_g + (size_t)pli * DM, ln_b + (size_t)pli * DM};
#ifndef NO_G_OUT
                    pg8::gemm_phase<EpiR, pg8::StaticOrder, true, true>(lds, g, S, E);
#endif
                  }
                }
                PH_END;
            }
            if (PH_RUN) { _Pragma("unroll 1") for (int rep_ = 0; rep_ < REP_LN; ++rep_) { if (rep_) { VM_WAIT(); __syncthreads(); }
                const bool last = (l == DEPTH - 1 && sub == NSUB - 1);
                const int nl = (sub == NSUB - 1) ? l + 1 : l, nsub = (sub == NSUB - 1) ? 0 : sub + 1;
                const float* g_ = ln_g + (size_t)(l * NSUB + sub) * DM; const float* b_ = ln_b + (size_t)(l * NSUB + sub) * DM;
                PIPE_HERE;
                const int bb = PP.pg;
                const float* md = last ? MOD : MOD + ((size_t)nl * BATCH + bb) * NMOD + (nsub * 3) * DM;
                f32x4 Gp[4][2], Bp[4][2];
#pragma unroll
                for (int j = 0; j < 4; ++j)
#pragma unroll
                    for (int e = 0; e < 2; ++e) { const int c = (lane + 64 * j) * 8 + 4 * e; const f32x4 gg = *(const f32x4*)(g_ + c), bbv = *(const f32x4*)(b_ + c);
                        if (last) { Gp[j][e] = gg; Bp[j][e] = bbv; }
                        else { const f32x4 sc1 = *(const f32x4*)(md + DM + c) + 1.0f, sh = *(const f32x4*)(md + c); Gp[j][e] = gg * sc1; Bp[j][e] = bbv * sc1 + sh; } }
                for (int m_ = pgw; m_ < SEQ; m_ += 4 * PNGW) {
                    LnRowRegs RR[4];
#pragma unroll
                    for (int q_ = 0; q_ < 4; ++q_) if (m_ + q_ * PNGW < SEQ) ln_row_load(RR[q_], V + (size_t)(bb * SEQ + ROWX(m_ + q_ * PNGW)) * DM, lane);
#pragma unroll
                    for (int q_ = 0; q_ < 4; ++q_) if (m_ + q_ * PNGW < SEQ) { const int m = bb * SEQ + ROWX(m_ + q_ * PNGW);
                        ln_row_finish_pc(RR[q_], last ? (float*)nullptr : STATS + 2 * (size_t)m, last ? args.out + (size_t)m * DM : (float*)nullptr, last ? (bf16*)nullptr : H + (size_t)m * DM, Gp, Bp, lane); } }
            } }
            PH_END;

}
__global__ void __launch_bounds__(NWAVES * 64, 2) fwd_kernel(Args args) {
    extern __shared__ __attribute__((aligned(16))) unsigned char lds_raw[];
    LAS unsigned char* lds = (LAS unsigned char*)lds_raw;
    volatile LAS unsigned* MISC = (volatile LAS unsigned*)(lds + MISC_OFF);
    const int tid = threadIdx.x, lane = tid & 63, wave = __builtin_amdgcn_readfirstlane(tid >> 6);
    const int G = gridDim.x, gw = blockIdx.x * NWAVES + wave, NGW = G * NWAVES, gt = blockIdx.x * (NWAVES * 64) + tid, NGT = G * NWAVES * 64;
    unsigned char* ws = args.ws;
    for (int u = tid; u < 128; u += NWAVES * 64) MISC[u] = 0u;
    __syncthreads();
    const int lo = args.ph_lo, hi = args.ph_hi;
    XcdBarrier bar; bar.bar = (unsigned*)(ws + WS_CTL) + CW_BAR; bar.x = 0; bar.st = nullptr; bar.gsize = gridDim.x;
    XcdBarrier pbar = bar;
    if (hi - lo > 1) { bar = xcd_barrier_post((unsigned*)(ws + WS_CTL) + CW_BAR, MISC + 8, gridDim.x);
        pbar = xcd_barrier_post((unsigned*)(ws + WS_CTL) + CW_PBAR + 4096 * (((int)blockIdx.x & 7) >> 1), MISC + 10, gridDim.x >> 2); }
    int ph = 0;

    const float* x_in = args.in[0]; const float* c_in = args.in[1]; const float* ada_w = args.in[2]; const float* ada_b = args.in[3];
    const float* ln_g = args.in[4]; const float* ln_b = args.in[5]; const float* lbl = args.in[10]; const float* hg_ng = args.in[11];
    float* X = args.out;
    float* MOD = (float*)(ws + WS_MOD); float* MODP = (float*)(ws + WS_MODP);
    float* V = (float*)(ws + WS_V); bf16* H = (bf16*)(ws + WS_H);
    unsigned char* R = ws + WS_R;

    if (PH_RUN) { _Pragma("unroll 1") for (int rep_ = 0; rep_ < REP_P0; ++rep_) { if (rep_) { VM_WAIT(); __syncthreads(); }
        LAS float* condT = (LAS float*)lds;
        for (int i = tid; i < BATCH * DM; i += NWAVES * 64) { const int b = i / DM, k = i % DM; condT[k * 4 + b] = silu_f(c_in[i]); }
        __syncthreads();
        for (int it = gw; it < 144 * 16; it += NGW) adaln_item(it, ada_w, MODP, condT, lane);
        __syncthreads();
        LAS float* scr = (LAS float*)(lds + wave * 16640);
        for (int it = gw; it < 5632 + 2816; it += NGW) { const int r = it < 5632 ? it : it - 5632 + CV_GU;
            convert_item(r, args.in[6], args.in[7], args.in[8], args.in[9], args.in[12], args.in[13], args.in[14], ws + WS_WTS, scr, lane); }
    } }
    PH_END;
    if (PH_RUN) { _Pragma("unroll 1") for (int rep_ = 0; rep_ < REP_LN; ++rep_) { if (rep_) { VM_WAIT(); __syncthreads(); }
        PIPE_HERE;
        {
            constexpr int NA = CV_IN + CV_A + CV_B + CV_O  , NB_ = 5632, NC_ = 2816, NREST = NA + NB_ + NC_ + CV_LAYER;
            const int lo_[5] = {0, (NREST * 19) / 100, (NREST * 42) / 100, (NREST * 69) / 100, NREST};
            const int r0 = PP.pg == 0 ? lo_[0] : PP.pg == 1 ? lo_[1] : PP.pg == 2 ? lo_[2] : lo_[3], r1 = PP.pg == 0 ? lo_[1] : PP.pg == 1 ? lo_[2] : PP.pg == 2 ? lo_[3] : lo_[4];
            LAS float* scr = (LAS float*)(lds + wave * 16640);
            for (int r = r0 + pgw; r < r1; r += PNGW) { int it;
                if (r < NA) it = CV_GU + CV_D + r; else if (r < NA + NB_) it = 5632 + (r - NA); else if (r < NA + NB_ + NC_) it = CV_GU + 2816 + (r - NA - NB_); else it = CV_LAYER + (r - NA - NB_ - NC_);
                convert_item(it, args.in[6], args.in[7], args.in[8], args.in[9], args.in[12], args.in[13], args.in[14], ws + WS_WTS, scr, lane); }
            asm volatile("s_waitcnt vmcnt(0)" ::: "memory"); __syncthreads();
            if (tid == 0) { __builtin_amdgcn_fence(__ATOMIC_RELEASE, "agent"); asm volatile("s_waitcnt vmcnt(0)" ::: "memory");
                (void)__hip_atomic_fetch_add((unsigned*)(ws + WS_CTL) + CW_CONV, 1u, __ATOMIC_RELAXED, __HIP_MEMORY_SCOPE_AGENT); }
        }
        {
            const int bb = PP.pg, PNT = PP.gp * NWAVES * 64;
            for (int i = PP.lw * (NWAVES * 64) + tid; i < DEPTH * NMOD; i += PNT) { const int l = i / NMOD, j = i % NMOD;
                float s = ada_b[l * NMOD + j];
#pragma unroll
                for (int ks = 0; ks < 16; ++ks) s += MODP[(size_t)(ks * 4 + bb) * (DEPTH * NMOD) + l * NMOD + j];
                MOD[((size_t)l * BATCH + bb) * NMOD + j] = s; } }
    } }
    PH_END;
    if (PH_RUN) { _Pragma("unroll 1") for (int rep_ = 0; rep_ < REP_LN; ++rep_) { if (rep_) { VM_WAIT(); __syncthreads(); }
        PIPE_HERE;
        const int bb = PP.pg; const float* md = MOD + (size_t)bb * NMOD;
        f32x4 sc1[8], shv[8];
#pragma unroll
        for (int j = 0; j < 8; ++j) { const int c = (lane + 64 * (j >> 1)) * 8 + 4 * (j & 1); sc1[j] = *(const f32x4*)(md + DM + c) + 1.0f; shv[j] = *(const f32x4*)(md + c); }
        for (int m_ = pgw; m_ < SEQ; m_ += 4 * PNGW) {
            f32x4 xr[4][8];
#pragma unroll
            for (int q_ = 0; q_ < 4; ++q_) if (m_ + q_ * PNGW < SEQ) {
#pragma unroll
                for (int j = 0; j < 8; ++j) xr[q_][j] = *(const f32x4*)(x_in + (size_t)(bb * SEQ + ROWX(m_ + q_ * PNGW)) * DM + (lane + 64 * (j >> 1)) * 8 + 4 * (j & 1)); }
#pragma unroll
            for (int q_ = 0; q_ < 4; ++q_) if (m_ + q_ * PNGW < SEQ) { bf16* hrow = H + (size_t)(bb * SEQ + ROWX(m_ + q_ * PNGW)) * DM;
#pragma unroll
                for (int j = 0; j < 4; ++j) { const int c = (lane + 64 * j) * 8;
                    const f32x4 h0 = xr[q_][2 * j] * sc1[2 * j] + shv[2 * j], h1 = xr[q_][2 * j + 1] * sc1[2 * j + 1] + shv[2 * j + 1];
                    v4u o; o.x = pk2(h0.x, h0.y); o.y = pk2(h0.z, h0.w); o.z = pk2(h1.x, h1.y); o.w = pk2(h1.z, h1.w); *(v4u*)(hrow + c) = o; } } }
    } }
    PH_END;

    sub_layer<0, 0>(args, lds, bar, pbar, lo, hi, wave, lane); sub_layer<0, 1>(args, lds, bar, pbar, lo, hi, wave, lane); sub_layer<0, 2>(args, lds, bar, pbar, lo, hi, wave, lane);
    sub_layer<1, 0>(args, lds, bar, pbar, lo, hi, wave, lane); sub_layer<1, 1>(args, lds, bar, pbar, lo, hi, wave, lane); sub_layer<1, 2>(args, lds, bar, pbar, lo, hi, wave, lane);
#undef PH_RUN
#undef PH_END
}

extern "C" void kernel_launch(void* const* d_in, const int* in_sizes, int n_in, void* d_out, int out_size, void* d_ws, size_t ws_size, hipStream_t stream) {
    static int grid = 0;
    if (grid == 0) {
        if (n_in != 15 || in_sizes[0] != MTOK * DM || out_size != MTOK * DM || ws_size < WS_END) { fprintf(stderr, "kernel_launch: unexpected shapes / workspace (n_in %d, ws %zu < %zu); nothing launched\n", n_in, ws_size, (size_t)WS_END); grid = -1; return; }
        int dev = 0, cus = 0, per_cu = 0;
        if (hipGetDevice(&dev) != hipSuccess || hipDeviceGetAttribute(&cus, hipDeviceAttributeMultiprocessorCount, dev) != hipSuccess) { grid = -1; return; }
        if (hipFuncSetAttribute((const void*)fwd_kernel, hipFuncAttributeMaxDynamicSharedMemorySize, LDS_BYTES) != hipSuccess) { fprintf(stderr, "kernel_launch: hipFuncSetAttribute failed\n"); grid = -1; return; }
        if (hipOccupancyMaxActiveBlocksPerMultiprocessor(&per_cu, (const void*)fwd_kernel, NWAVES * 64, LDS_BYTES) != hipSuccess || per_cu < 1) fprintf(stderr, "kernel_launch: occupancy query says %d\n", per_cu);
        (void)hipGetLastError();
        grid = cus - (cus % 8);
    }
    if (grid < 0) return;
    if (hipMemsetAsync((char*)d_ws + WS_CTL, 0, CTL_ZERO_BYTES, stream) != hipSuccess) return;
    Args a{};
    for (int i = 0; i < 15; ++i) a.in[i] = (const float*)d_in[i];
    a.out = (float*)d_out; a.ws = (unsigned char*)d_ws;
#if MK_N_LAUNCHES == 1
    a.ph_lo = 0; a.ph_hi = N_PHASES;
    hipLaunchKernelGGL(fwd_kernel, dim3(grid), dim3(NWAVES * 64), LDS_BYTES, stream, a);
#else
    for (int p = 0; p < N_PHASES; ++p) { a.ph_lo = p; a.ph_hi = p + 1; hipLaunchKernelGGL(fwd_kernel, dim3(grid), dim3(NWAVES * 64), LDS_BYTES, stream, a); }
#endif
}
```
